# Optimizing an MI355X kernel written in HIP

```python
import jax
import jax.numpy as jnp
from jax import lax
import numpy as np


D_MODEL = 1024
BATCH = 8
SEQ = 2048
DEPTH = 4

HEAD_DIM = 64
FOX_HEADS = 8
SB_HEADS = 8
FOX_WIDTH = FOX_HEADS * HEAD_DIM
SB_WIDTH = SB_HEADS * HEAD_DIM
CONV_WIDTH = 512
CONV_K = 3
N_BRANCH = 3
D_FF = 2816
Q_BLOCK = 128
NORM_EPS = 1e-6
NEG_INF = -1e30

SPLIT_POINTS = [
    3 * CONV_WIDTH,
    3 * CONV_WIDTH + 3 * FOX_WIDTH,
    3 * CONV_WIDTH + 3 * FOX_WIDTH + FOX_HEADS,
    3 * CONV_WIDTH + 3 * FOX_WIDTH + FOX_HEADS + 3 * SB_WIDTH,
]
D_IN = 3 * CONV_WIDTH + 3 * FOX_WIDTH + FOX_HEADS + 3 * SB_WIDTH + N_BRANCH * D_MODEL

kernel_name = 'hybrid_gatedconv_fox_stickbreak_convglu'


def rmsnorm(x, g):
    xf = x.astype(jnp.float32)
    y = xf * lax.rsqrt(jnp.mean(xf * xf, axis=-1, keepdims=True) + NORM_EPS)
    return (y * g.astype(jnp.float32)).astype(x.dtype)


def causal_dwconv(x, w):
    k = w.shape[0]
    return lax.conv_general_dilated(
        x, w[:, None, :].astype(x.dtype), window_strides=(1,), padding=[(k - 1, 0)],
        dimension_numbers=('NWC', 'WIO', 'NWC'), feature_group_count=x.shape[-1])


def _heads(t, n):
    b, s, _ = t.shape
    return t.reshape(b, s, n, HEAD_DIM).transpose(0, 2, 1, 3)


def _to_blocks(t):
    b, h, s = t.shape[:3]
    t = t.reshape(b, h, s // Q_BLOCK, Q_BLOCK, *t.shape[3:])
    return jnp.moveaxis(t, 2, 0)


def _from_blocks(o):
    nb, b, h, q, d = o.shape
    return o.transpose(1, 0, 3, 2, 4).reshape(b, nb * q, h * d)


def short_conv_mixer(b_gate, c_gate, h, conv_w):
    return b_gate * causal_dwconv(c_gate * h, conv_w)


def forgetting_attention(q, k, v, log_f, qn_g, kn_g):
    q = rmsnorm(_heads(q, FOX_HEADS), qn_g)
    k = rmsnorm(_heads(k, FOX_HEADS), kn_g)
    v = _heads(v, FOX_HEADS)
    c = lax.cumsum(log_f, axis=1).transpose(0, 2, 1)
    pos = jnp.arange(q.shape[2])
    scale = HEAD_DIM ** -0.5

    def block(args):
        qb, cqb, qpos = args
        logits = (jnp.einsum('bhqd,bhkd->bhqk', qb, k).astype(jnp.float32) * scale
                  + cqb[..., None] - c[:, :, None, :])
        logits = jnp.where(pos[None, :] <= qpos[:, None], logits, NEG_INF)
        p = jax.nn.softmax(logits, axis=-1)
        return jnp.einsum('bhqk,bhkd->bhqd', p.astype(v.dtype), v)

    out = lax.map(block, (_to_blocks(q), _to_blocks(c), pos.reshape(-1, Q_BLOCK)))
    return _from_blocks(out)


def stick_breaking_attention(q, k, v):
    q = _heads(q, SB_HEADS)
    k = _heads(k, SB_HEADS)
    v = _heads(v, SB_HEADS)
    pos = jnp.arange(q.shape[2])
    scale = HEAD_DIM ** -0.5

    def block(args):
        qb, qpos = args
        z = jnp.einsum('bhqd,bhkd->bhqk', qb, k).astype(jnp.float32) * scale
        strict = pos[None, :] < qpos[:, None]
        log_1m = jnp.where(strict, jax.nn.log_sigmoid(-z), 0.0)
        suffix = lax.cumsum(log_1m, axis=log_1m.ndim - 1, reverse=True) - log_1m
        a = jnp.where(strict, jnp.exp(jax.nn.log_sigmoid(z) + suffix), 0.0)
        return jnp.einsum('bhqk,bhkd->bhqd', a.astype(v.dtype), v)

    out = lax.map(block, (_to_blocks(q), pos.reshape(-1, Q_BLOCK)))
    return _from_blocks(out)


def setup_inputs(seed: int = 0) -> dict:
    key = jax.random.key(seed)
    ks = jax.random.split(key, 17)
    f32 = jnp.float32
    nrm = lambda k, shape, s: jax.random.normal(k, shape, f32) * s
    return {
        'x': nrm(ks[0], (BATCH, SEQ, D_MODEL), 1.0),
        'norm1_g': 1.0 + nrm(ks[1], (DEPTH, D_MODEL), 0.05),
        'w_in': nrm(ks[2], (DEPTH, D_MODEL, D_IN), D_MODEL ** -0.5),
        'fox_f_bias': 2.0 + nrm(ks[3], (DEPTH, FOX_HEADS), 0.5),
        'gate_bias': nrm(ks[4], (DEPTH, N_BRANCH * D_MODEL), 0.1),
        'conv_w': nrm(ks[5], (DEPTH, CONV_K, CONV_WIDTH), CONV_K ** -0.5),
        'fox_q_norm_g': 1.0 + nrm(ks[6], (DEPTH, HEAD_DIM), 0.05),
        'fox_k_norm_g': 1.0 + nrm(ks[7], (DEPTH, HEAD_DIM), 0.05),
        'w_proj_conv': nrm(ks[8], (DEPTH, CONV_WIDTH, D_MODEL), CONV_WIDTH ** -0.5),
        'w_proj_fox': nrm(ks[9], (DEPTH, FOX_WIDTH, D_MODEL), FOX_WIDTH ** -0.5),
        'w_proj_sb': nrm(ks[10], (DEPTH, SB_WIDTH, D_MODEL), SB_WIDTH ** -0.5),
        'w_out': nrm(ks[11], (DEPTH, D_MODEL, D_MODEL), D_MODEL ** -0.5),
        'norm2_g': 1.0 + nrm(ks[12], (DEPTH, D_MODEL), 0.05),
        'w_up': nrm(ks[13], (DEPTH, D_MODEL, 2 * D_FF), D_MODEL ** -0.5),
        'ffn_conv_w': nrm(ks[14], (DEPTH, CONV_K, D_FF), CONV_K ** -0.5),
        'ffn_conv_b': nrm(ks[15], (DEPTH, D_FF), 0.02),
        'w_down': nrm(ks[16], (DEPTH, D_FF, D_MODEL), D_FF ** -0.5),
    }


def reference(x, norm1_g, w_in, fox_f_bias, gate_bias, conv_w, fox_q_norm_g, fox_k_norm_g,
              w_proj_conv, w_proj_fox, w_proj_sb, w_out, norm2_g, w_up, ffn_conv_w,
              ffn_conv_b, w_down):
    for l in range(DEPTH):
        hn = rmsnorm(x, norm1_g[l])
        proj = hn @ w_in[l]
        conv_bch, fox_qkv, fox_f, sb_qkv, gate_logits = jnp.split(proj, SPLIT_POINTS, axis=-1)

        cb, cc, ch = jnp.split(conv_bch, 3, axis=-1)
        y_conv = short_conv_mixer(cb, cc, ch, conv_w[l]) @ w_proj_conv[l]

        fq, fk, fv = jnp.split(fox_qkv, 3, axis=-1)
        log_f = jax.nn.log_sigmoid(fox_f.astype(jnp.float32) + fox_f_bias[l].astype(jnp.float32))
        y_fox = forgetting_attention(fq, fk, fv, log_f, fox_q_norm_g[l], fox_k_norm_g[l]) @ w_proj_fox[l]

        sq, sk, sv = jnp.split(sb_qkv, 3, axis=-1)
        y_sb = stick_breaking_attention(sq, sk, sv) @ w_proj_sb[l]

        g_conv, g_fox, g_sb = jnp.split(jax.nn.sigmoid(gate_logits + gate_bias[l]), 3, axis=-1)
        x = x + (g_conv * y_conv + g_fox * y_fox + g_sb * y_sb) @ w_out[l]

        hn = rmsnorm(x, norm2_g[l])
        u_gate, u_val = jnp.split(hn @ w_up[l], 2, axis=-1)
        act = jax.nn.silu(causal_dwconv(u_gate, ffn_conv_w[l]) + ffn_conv_b[l])
        x = x + (act * u_val) @ w_down[l]
    return x
```

```cpp
#include <hip/hip_runtime.h>
#include <hip/hip_cooperative_groups.h>
#include <cstdio>
#include <cstdint>
namespace cg = cooperative_groups;

constexpr int DM = 1024, BATCH = 8, SEQ = 2048, DEPTH = 4, MTOK = BATCH * SEQ;
constexpr int DIN = 7688, NIN = 7936, DFF = 2816, NUP = 2 * DFF;
constexpr int PA_P = 4608, G_P = 3072, MIX_P = 1536;
constexpr float NORM_EPS = 1e-6f;
constexpr float LOG2E = 1.4426950408889634f;
constexpr float SSQ_SCALE = 1048576.0f, SSQ_INV = 1.0f / 1048576.0f;

namespace pg8 {
#define PG8_LAS __attribute__((address_space(3)))
typedef unsigned short bf16_t;
typedef short bf16x8 __attribute__((ext_vector_type(8)));
typedef float f32x4 __attribute__((ext_vector_type(4)));
typedef unsigned u32x4 __attribute__((ext_vector_type(4)));
typedef unsigned u32x2 __attribute__((ext_vector_type(2)));
constexpr int BM = 256, BK = 64, HALF = 128, HTB = HALF * BK * 2  , STAGE_BYTES = 8 * HTB, NXCD = 8, WGM = 8;

__host__ __device__ __forceinline__ int lds_byte(int r, int c) { const int st = (r >> 4) * 2 + (c >> 5), rr = r & 15, cc = c & 31, ob = rr * 64 + cc * 2; return st * 1024 + (ob ^ (((ob >> 9) & 1) << 5)); }
__host__ __device__ __forceinline__ void stage_rc(int b, int& R, int& C) { const int st = b / 1024, sb = b % 1024, swz = sb ^ (((sb >> 9) & 1) << 5); R = (st >> 1) * 16 + swz / 64; C = (st & 1) * 32 + (swz % 64) / 2; }
__host__ __device__ __forceinline__ int perm32(int rho) { const int n = rho >> 4, i = rho & 15; return 8 * (i >> 2) + 4 * n + (i & 3); }

struct Unit { int pm, pn; };
struct Gemm { const bf16_t* A; const bf16_t* Bt; int M, N, K, lda, ldb, a_div, a_colstep, nbt; };

struct StaticOrder {
    int nM, nN, nwg, G, c;
    __host__ __device__ void init(int M, int N, int G_, int c_) { nM = M / BM; nN = N / BM; nwg = nM * nN; G = G_; c = c_; }
    __host__ __device__ bool next(int i, Unit& u) const {
        const long L = (long)i * G + c; if (L >= nwg) return false;
        int wgid = (int)L; { const int q = nwg / NXCD, r = nwg % NXCD, xcd = wgid % NXCD, off = wgid / NXCD; wgid = (xcd < r ? xcd * (q + 1) : r * (q + 1) + (xcd - r) * q) + off; }
        const int nig = WGM * nN, gid = wgid / nig, fm = gid * WGM, gsz = (nM - fm) < WGM ? (nM - fm) : WGM;
        u.pm = fm + ((wgid % nig) % gsz); u.pn = (wgid % nig) / gsz; return true;
    }
    __device__ __forceinline__ void a_ready(const Unit&) const {}
    __device__ __forceinline__ void done(const Unit&) const {}
};


__device__ __forceinline__ unsigned cvt_pk_bf16(float lo, float hi) { unsigned r; asm volatile("v_cvt_pk_bf16_f32 %0, %1, %2" : "=v"(r) : "v"(lo), "v"(hi)); return r; }
__device__ __forceinline__ float bflo(unsigned u) { return __uint_as_float(u << 16); }
__device__ __forceinline__ float bfhi(unsigned u) { return __uint_as_float(u & 0xffff0000u); }
__device__ __forceinline__ float sigmoidf_(float x) { return __builtin_amdgcn_rcpf(1.0f + __expf(-x)); }

struct EpiIn {
    static constexpr bool PERM = true, AFTER_DRAIN = false; static constexpr int HOOK_EVERY = 0;
    bf16_t* PA; bf16_t* G; float* LF; const unsigned long long* ssq; const float* gbias; const float* fbias;
    __device__ __forceinline__ void operator()(const f32x4 (&acc)[2][2][4][2], const Unit& u, int wr, int wc, int fr, int fq) const {
        const int row0 = u.pm * BM + wr * 64 + fr;
        const int col0 = u.pn * BM + wc * 32 + 8 * fq;
        unsigned long long sq[2][4];
#pragma unroll
        for (int ai = 0; ai < 2; ++ai)
#pragma unroll
            for (int m = 0; m < 4; ++m) sq[ai][m] = ssq[row0 + ai * HALF + m * 16];
        const bool gate = (u.pn >= 18) && (u.pn < 30);
        float rs[2][4];
#pragma unroll
        for (int ai = 0; ai < 2; ++ai)
#pragma unroll
            for (int m = 0; m < 4; ++m) rs[ai][m] = rsqrtf((float)sq[ai][m] * (SSQ_INV / DM) + NORM_EPS);
        if (u.pn < 30) {
            bf16_t* base = gate ? G + (col0 - PA_P) : PA + col0; const int ldc = gate ? G_P : PA_P;
#pragma unroll
            for (int bj = 0; bj < 2; ++bj) {
                f32x4 b0 = (f32x4){0.f, 0.f, 0.f, 0.f}, b1 = b0;
                if (gate) { b0 = *(const f32x4*)(gbias + (col0 - PA_P) + bj * HALF); b1 = *(const f32x4*)(gbias + (col0 - PA_P) + bj * HALF + 4); }
#pragma unroll
                for (int ai = 0; ai < 2; ++ai)
#pragma unroll
                    for (int m = 0; m < 4; ++m) { const int row = row0 + ai * HALF + m * 16;
                        f32x4 v0 = acc[ai][bj][m][0] * rs[ai][m] + b0, v1 = acc[ai][bj][m][1] * rs[ai][m] + b1;
                        if (gate) {
#pragma unroll
                            for (int e = 0; e < 4; ++e) { v0[e] = sigmoidf_(v0[e]); v1[e] = sigmoidf_(v1[e]); } }
                        u32x4 w; w.x = cvt_pk_bf16(v0[0], v0[1]); w.y = cvt_pk_bf16(v0[2], v0[3]); w.z = cvt_pk_bf16(v1[0], v1[1]); w.w = cvt_pk_bf16(v1[2], v1[3]);
                        *(u32x4*)(base + (size_t)row * ldc + bj * HALF) = w; }
            }
        } else {
            if (wc == 0 && fq == 0) {
#pragma unroll
                for (int ai = 0; ai < 2; ++ai)
#pragma unroll
                    for (int m = 0; m < 4; ++m) { const int row = row0 + ai * HALF + m * 16;
                        f32x4 v0 = acc[ai][0][m][0] * rs[ai][m] + *(const f32x4*)(fbias), v1 = acc[ai][0][m][1] * rs[ai][m] + *(const f32x4*)(fbias + 4);
#pragma unroll
                        for (int e = 0; e < 4; ++e) { v0[e] = fminf(v0[e], 0.f) - __logf(1.0f + __expf(-fabsf(v0[e]))); v1[e] = fminf(v1[e], 0.f) - __logf(1.0f + __expf(-fabsf(v1[e]))); }
                        *(f32x4*)(LF + (size_t)row * 8) = v0; *(f32x4*)(LF + (size_t)row * 8 + 4) = v1; }
            }
        }
    }
};
__device__ __forceinline__ float dpp_ror1(float v) { return __int_as_float(__builtin_amdgcn_update_dpp(0, __float_as_int(v), 0x121, 0xf, 0xf, false)); }
__device__ __forceinline__ float dpp_ror2(float v) { return __int_as_float(__builtin_amdgcn_update_dpp(0, __float_as_int(v), 0x122, 0xf, 0xf, false)); }
struct EpiGlu {
    static constexpr bool PERM = true, AFTER_DRAIN = false; static constexpr int HOOK_EVERY = 0;
    bf16_t* H; float* SG; float* SV; const unsigned long long* ssq; const float* cw; const float* cb;
    __device__ __forceinline__ void operator()(const f32x4 (&acc)[2][2][4][2], const Unit& u, int wr, int wc, int fr, int fq) const {
        const int row0 = u.pm * BM + wr * 64 + fr;
        unsigned long long sq[2][4];
#pragma unroll
        for (int ai = 0; ai < 2; ++ai)
#pragma unroll
            for (int m = 0; m < 4; ++m) sq[ai][m] = ssq[row0 + ai * HALF + m * 16];
        float rsv[2][4];
#pragma unroll
        for (int ai = 0; ai < 2; ++ai)
#pragma unroll
            for (int m = 0; m < 4; ++m) rsv[ai][m] = rsqrtf((float)sq[ai][m] * (SSQ_INV / DM) + NORM_EPS);
#pragma unroll
        for (int n = 0; n < 2; ++n) {
            const int c0 = u.pn * HALF + wc * 32 + 8 * fq + 4 * n;
            const f32x4 w0 = *(const f32x4*)(cw + c0), w1 = *(const f32x4*)(cw + DFF + c0), w2 = *(const f32x4*)(cw + 2 * DFF + c0), bb = *(const f32x4*)(cb + c0);
#pragma unroll
            for (int ai = 0; ai < 2; ++ai) {
                const int blk = u.pm * 4 + ai * 2 + wr;
                f32x4 p1 = (f32x4){0.f, 0.f, 0.f, 0.f}, p2 = p1;
#pragma unroll
                for (int m = 0; m < 4; ++m) { const int row = row0 + ai * HALF + m * 16; const float rs = rsv[ai][m];
                    const f32x4 g = acc[ai][0][m][n] * rs, v = acc[ai][1][m][n] * rs;
                    f32x4 r1, r2;
#pragma unroll
                    for (int e = 0; e < 4; ++e) { r1[e] = dpp_ror1(g[e]); r2[e] = dpp_ror2(g[e]); }
                    const f32x4 q1 = (fr >= 1) ? r1 : p1, q2 = (fr >= 2) ? r2 : p2;
                    p1 = r1; p2 = r2;
                    f32x4 pre = w0 * q2 + w1 * q1 + w2 * g + bb, hv;
#pragma unroll
                    for (int e = 0; e < 4; ++e) hv[e] = pre[e] * __builtin_amdgcn_rcpf(1.0f + __builtin_amdgcn_exp2f(-LOG2E * pre[e])) * v[e];
                    if (m == 0) { if (fr < 2) { *(f32x4*)(SG + ((size_t)blk * 4 + 2 + fr) * DFF + c0) = g; *(f32x4*)(SV + ((size_t)blk * 2 + fr) * DFF + c0) = v; } }
                    if (m == 3) { if (fr >= 14) *(f32x4*)(SG + ((size_t)blk * 4 + (fr - 14)) * DFF + c0) = g; }
                    if (m > 0 || fr >= 2) { u32x2 w; w.x = cvt_pk_bf16(hv[0], hv[1]); w.y = cvt_pk_bf16(hv[2], hv[3]); *(u32x2*)(H + (size_t)row * DFF + c0) = w; }
                    asm volatile("" ::: "memory"); }
            }
        }
    }
};
struct EpiMerge {
    static constexpr bool PERM = true, AFTER_DRAIN = false; static constexpr int HOOK_EVERY = 8;
    bf16_t* O; const bf16_t* G;
    __device__ __forceinline__ void mid(f32x4 (&acc)[2][2][4][2], const Unit& u, int seg, int wr, int wc, int fr, int fq) const {
        int row0 = u.pm * BM + wr * 64 + fr; const int col0 = u.pn * BM + wc * 32 + 8 * fq;
        asm volatile("" : "+v"(row0));
#pragma unroll
        for (int aim = 0; aim < 4; ++aim) { const int ai = aim >> 1, mb = (aim & 1) * 2;
            u32x4 ga[2][2], gb[2][2];
#pragma unroll
            for (int mm = 0; mm < 2; ++mm) { const bf16_t* gp = G + (size_t)(row0 + ai * HALF + (mb + mm) * 16) * G_P + col0 + (seg - 1) * 1024;
#pragma unroll
                for (int bj = 0; bj < 2; ++bj) { ga[mm][bj] = *(const u32x4*)(gp + bj * HALF); gb[mm][bj] = *(const u32x4*)(gp + bj * HALF + 1024); } }
#pragma unroll
            for (int mm = 0; mm < 2; ++mm)
#pragma unroll
                for (int bj = 0; bj < 2; ++bj) { const u32x4 a = ga[mm][bj], b = gb[mm][bj]; const int m = mb + mm;
                    f32x4& a0 = acc[ai][bj][m][0]; f32x4& a1 = acc[ai][bj][m][1];
                    a0[0] *= fmaxf(bflo(a.x), 1e-6f) * __builtin_amdgcn_rcpf(fmaxf(bflo(b.x), 1e-6f)); a0[1] *= fmaxf(bfhi(a.x), 1e-6f) * __builtin_amdgcn_rcpf(fmaxf(bfhi(b.x), 1e-6f));
                    a0[2] *= fmaxf(bflo(a.y), 1e-6f) * __builtin_amdgcn_rcpf(fmaxf(bflo(b.y), 1e-6f)); a0[3] *= fmaxf(bfhi(a.y), 1e-6f) * __builtin_amdgcn_rcpf(fmaxf(bfhi(b.y), 1e-6f));
                    a1[0] *= fmaxf(bflo(a.z), 1e-6f) * __builtin_amdgcn_rcpf(fmaxf(bflo(b.z), 1e-6f)); a1[1] *= fmaxf(bfhi(a.z), 1e-6f) * __builtin_amdgcn_rcpf(fmaxf(bfhi(b.z), 1e-6f));
                    a1[2] *= fmaxf(bflo(a.w), 1e-6f) * __builtin_amdgcn_rcpf(fmaxf(bflo(b.w), 1e-6f)); a1[3] *= fmaxf(bfhi(a.w), 1e-6f) * __builtin_amdgcn_rcpf(fmaxf(bfhi(b.w), 1e-6f)); }
            asm volatile("" ::: "memory"); }
    }
    __device__ __forceinline__ void operator()(const f32x4 (&acc)[2][2][4][2], const Unit& u, int wr, int wc, int fr, int fq) const {
        const int row0 = u.pm * BM + wr * 64 + fr, col0 = u.pn * BM + wc * 32 + 8 * fq;
#pragma unroll
        for (int aim = 0; aim < 4; ++aim) { const int ai = aim >> 1, mb = (aim & 1) * 2;
            u32x4 gv[2][2];
#pragma unroll
            for (int mm = 0; mm < 2; ++mm)
#pragma unroll
                for (int bj = 0; bj < 2; ++bj) gv[mm][bj] = *(const u32x4*)(G + (size_t)(row0 + ai * HALF + (mb + mm) * 16) * G_P + 2048 + col0 + bj * HALF);
#pragma unroll
            for (int mm = 0; mm < 2; ++mm) { const int m = mb + mm; const int row = row0 + ai * HALF + m * 16;
#pragma unroll
                for (int bj = 0; bj < 2; ++bj) { const u32x4 g = gv[mm][bj];
                    const f32x4 a0 = acc[ai][bj][m][0], a1 = acc[ai][bj][m][1];
                    u32x4 w; w.x = cvt_pk_bf16(a0[0] * fmaxf(bflo(g.x), 1e-6f), a0[1] * fmaxf(bfhi(g.x), 1e-6f)); w.y = cvt_pk_bf16(a0[2] * fmaxf(bflo(g.y), 1e-6f), a0[3] * fmaxf(bfhi(g.y), 1e-6f));
                    w.z = cvt_pk_bf16(a1[0] * fmaxf(bflo(g.z), 1e-6f), a1[1] * fmaxf(bfhi(g.z), 1e-6f)); w.w = cvt_pk_bf16(a1[2] * fmaxf(bflo(g.w), 1e-6f), a1[3] * fmaxf(bfhi(g.w), 1e-6f));
                    *(u32x4*)(O + (size_t)row * DM + col0 + bj * HALF) = w; } }
            asm volatile("" ::: "memory"); }
    }
};
struct EpiRes {
    static constexpr bool PERM = false, AFTER_DRAIN = false; static constexpr int HOOK_EVERY = 0;
    const float* Xin; float* X; bf16_t* XB; unsigned long long* ssq_out;
    __device__ __forceinline__ void operator()(const f32x4 (&acc)[2][2][4][2], const Unit& u, int wr, int wc, int fr, int fq) const {
        const int row0 = u.pm * BM + wr * 64 + fr, col0 = u.pn * BM + wc * 32 + 4 * fq;
#pragma unroll
        for (int ai = 0; ai < 2; ++ai)
#pragma unroll
            for (int m = 0; m < 4; ++m) { const int row = row0 + ai * HALF + m * 16; const size_t off = (size_t)row * DM + col0; float s = 0.f;
#pragma unroll
                for (int bj = 0; bj < 2; ++bj)
#pragma unroll
                    for (int n = 0; n < 2; ++n) { const size_t o2 = off + bj * HALF + n * 16; const f32x4 xn = *(const f32x4*)(Xin + o2) + acc[ai][bj][m][n];
                        *(f32x4*)(X + o2) = xn;
                        if (XB) { u32x2 w; w.x = cvt_pk_bf16(xn[0], xn[1]); w.y = cvt_pk_bf16(xn[2], xn[3]); *(u32x2*)(XB + o2) = w; }
                        s += (xn[0] * xn[0] + xn[1] * xn[1]) + (xn[2] * xn[2] + xn[3] * xn[3]); }
                if (ssq_out) { s += __shfl_xor(s, 16); s += __shfl_xor(s, 32); if (fq == 0) atomicAdd(ssq_out + row, (unsigned long long)__float2ll_rn(s * SSQ_SCALE)); } }
    }
};

template <class Epi, class Sched, bool ALIGN_EPI = false, bool SP2 = false>
__device__ __forceinline__ void gemm_phase(PG8_LAS unsigned char* lds, const Gemm g, const Sched& S, const Epi& E) {
    int tid_ = threadIdx.x; asm volatile("" : "+v"(tid_));
    const int tid = tid_, wid = __builtin_amdgcn_readfirstlane(tid >> 6), lane = tid & 63, wr = wid >> 2, wc = wid & 3, fr = lane & 15, fq = lane >> 4;
    const int K = g.K, nt = K / BK;
    unsigned voffA[2], voffB[2];
#pragma unroll
    for (int i = 0; i < 2; ++i) { int R, C; stage_rc(tid * 16 + i * 8192, R, C); const int Rb = Epi::PERM ? ((R & ~31) + perm32(R & 31)) : R;
        voffA[i] = (unsigned)(R * g.lda + C) * 2u; voffB[i] = (unsigned)(Rb * g.ldb + C) * 2u; }
    const size_t kstep = (size_t)(BK * 2);
    const size_t hstepA = (size_t)HALF * g.lda * 2, hstepB = (size_t)HALF * g.ldb * 2;
    const size_t tstepA = 2 * hstepA, tstepB = 2 * hstepB;
    const unsigned ldsw = (unsigned)wid * 1024u;
    const int aoff = lds_byte(wr * 64 + fr, fq * 8), boff = lds_byte(wc * 32 + fr, fq * 8);
#define PG8_SA(b, h) (((b) * 2 + (h)) * HTB)
#define PG8_SB(b, h) ((4 + (b) * 2 + (h)) * HTB)
#define PG8_STAGE(bufoff, gbase, voff) do { _Pragma("unroll") for (int _i = 0; _i < 2; ++_i) \
        __builtin_amdgcn_global_load_lds((const unsigned*)((const char*)(gbase) + (voff)[_i]), (PG8_LAS unsigned*)(lds + (bufoff) + ldsw + _i * 8192), 16, 0, 0); } while (0)
#define PG8_LDA(dst, b, h) do { _Pragma("unroll") for (int m = 0; m < 4; ++m) _Pragma("unroll") for (int k = 0; k < 2; ++k) dst[m][k] = *(const PG8_LAS bf16x8*)(lds + PG8_SA(b, h) + aoff + m * 2048 + k * 1024); } while (0)
#define PG8_LDB(dst, b, h) do { _Pragma("unroll") for (int n = 0; n < 2; ++n) _Pragma("unroll") for (int k = 0; k < 2; ++k) dst[n][k] = *(const PG8_LAS bf16x8*)(lds + PG8_SB(b, h) + boff + n * 2048 + k * 1024); } while (0)
#define PG8_MMA(ai, bj, At, Bt) do { __builtin_amdgcn_s_setprio(1); _Pragma("unroll") for (int m = 0; m < 4; ++m) _Pragma("unroll") for (int n = 0; n < 2; ++n) _Pragma("unroll") for (int k = 0; k < 2; ++k) \
        acc[ai][bj][m][n] = __builtin_amdgcn_mfma_f32_16x16x32_bf16(Bt[n][k], At[m][k], acc[ai][bj][m][n], 0, 0, 0); __builtin_amdgcn_s_setprio(0); } while (0)
#define PG8_WAIT_V(n) asm volatile("s_waitcnt vmcnt(" #n ")" ::: "memory")
#define PG8_WAIT_L(n) asm volatile("s_waitcnt lgkmcnt(" #n ")" ::: "memory")
#define PG8_BAR __builtin_amdgcn_s_barrier()
#define PG8_SCHED __builtin_amdgcn_sched_barrier(0)
    Unit cur, nxt; int ui = 0;
    if (!S.next(0, cur)) return;
    f32x4 acc[2][2][4][2];
#pragma unroll
    for (int a = 0; a < 2; ++a)
#pragma unroll
        for (int b = 0; b < 2; ++b)
#pragma unroll
            for (int m = 0; m < 4; ++m)
#pragma unroll
                for (int n = 0; n < 2; ++n) acc[a][b][m][n] = (f32x4){0.f, 0.f, 0.f, 0.f};
    bf16x8 At[4][2], B0[2][2], B1[2][2];
    const char* cA = (const char*)g.A + (size_t)cur.pm * tstepA + (size_t)(cur.pn / g.a_div) * g.a_colstep; const char* cB = (const char*)g.Bt + (size_t)cur.pn * tstepB;
    S.a_ready(cur);
    if constexpr (SP2) {
        PG8_STAGE(PG8_SB(0, 0), cB, voffB); PG8_STAGE(PG8_SB(0, 1), cB + hstepB, voffB); PG8_STAGE(PG8_SA(0, 0), cA, voffA); PG8_STAGE(PG8_SA(0, 1), cA + hstepA, voffA);
        if (wr == 1) PG8_BAR;
        PG8_WAIT_V(2); PG8_BAR;
        PG8_STAGE(PG8_SB(1, 0), cB + kstep, voffB); PG8_STAGE(PG8_SA(1, 0), cA + kstep, voffA); PG8_STAGE(PG8_SB(1, 1), cB + hstepB + kstep, voffB);
        PG8_WAIT_V(6); PG8_BAR;
    } else {
        PG8_STAGE(PG8_SB(0, 0), cB, voffB); PG8_STAGE(PG8_SA(0, 0), cA, voffA); PG8_STAGE(PG8_SB(0, 1), cB + hstepB, voffB); PG8_STAGE(PG8_SA(0, 1), cA + hstepA, voffA);
        if (wr == 1) PG8_BAR;
        PG8_WAIT_V(4); PG8_BAR;
        PG8_STAGE(PG8_SB(1, 0), cB + kstep, voffB); PG8_STAGE(PG8_SA(1, 0), cA + kstep, voffA); PG8_STAGE(PG8_SB(1, 1), cB + hstepB + kstep, voffB);
        PG8_WAIT_V(6); PG8_BAR;
    }
    for (;;) {
        const bool has_next = S.next(ui + 1, nxt);
        const char* nA = has_next ? (const char*)g.A + (size_t)nxt.pm * tstepA + (size_t)(nxt.pn / g.a_div) * g.a_colstep : cA; const char* nB = has_next ? (const char*)g.Bt + (size_t)nxt.pn * tstepB : cB;
        int tb = 0;
        for (int t = 0; t < nt; t += 2) {
            const bool last = (t == nt - 2);
            if constexpr (Epi::HOOK_EVERY > 0) { if (t > 0 && (t % Epi::HOOK_EVERY) == 0) E.mid(acc, cur, t / Epi::HOOK_EVERY, wr, wc, fr, fq); }
            const char* a1 = cA + (size_t)(t + 1) * kstep;
            const char* a2 = last ? nA : cA + (size_t)(t + 2) * kstep; tb += 2; if (tb >= g.nbt) tb -= g.nbt; const char* b2 = last ? nB : cB + (size_t)tb * kstep;
            const char* a3 = a2 + kstep; const char* b3 = b2 + kstep;
            if (last && has_next) S.a_ready(nxt);
            if constexpr (SP2) {
            PG8_LDB(B0, 0, 0); PG8_LDB(B1, 0, 1); PG8_SCHED; PG8_LDA(At, 0, 0); PG8_STAGE(PG8_SA(1, 1), a1 + hstepA, voffA);
            PG8_WAIT_V(8); PG8_WAIT_L(0); PG8_BAR; PG8_MMA(0, 0, At, B0); PG8_MMA(0, 1, At, B1); PG8_BAR; PG8_SCHED;
            PG8_LDA(At, 0, 1); PG8_STAGE(PG8_SB(0, 0), b2, voffB); PG8_STAGE(PG8_SB(0, 1), b2 + hstepB, voffB); PG8_STAGE(PG8_SA(0, 0), a2, voffA);
            PG8_WAIT_V(8); PG8_WAIT_L(0); PG8_BAR; PG8_MMA(1, 0, At, B0); PG8_MMA(1, 1, At, B1); PG8_BAR; PG8_SCHED;
            PG8_LDB(B0, 1, 0); PG8_LDB(B1, 1, 1); PG8_SCHED; PG8_LDA(At, 1, 0); PG8_STAGE(PG8_SA(0, 1), a2 + hstepA, voffA);
            PG8_WAIT_V(8); PG8_WAIT_L(0); PG8_BAR; PG8_MMA(0, 0, At, B0); PG8_MMA(0, 1, At, B1); PG8_BAR; PG8_SCHED;
            PG8_LDA(At, 1, 1); PG8_STAGE(PG8_SB(1, 0), b3, voffB); PG8_STAGE(PG8_SB(1, 1), b3 + hstepB, voffB); PG8_STAGE(PG8_SA(1, 0), a3, voffA);
            PG8_WAIT_V(8); PG8_WAIT_L(0); PG8_BAR; PG8_MMA(1, 0, At, B0); PG8_MMA(1, 1, At, B1); PG8_BAR; PG8_SCHED;
            } else {
            PG8_LDB(B0, 0, 0); PG8_SCHED; PG8_LDA(At, 0, 0); PG8_STAGE(PG8_SA(1, 1), a1 + hstepA, voffA);
            PG8_WAIT_L(8); PG8_BAR; PG8_WAIT_L(0); PG8_MMA(0, 0, At, B0); PG8_BAR; PG8_SCHED;
            PG8_LDB(B1, 0, 1); PG8_STAGE(PG8_SB(0, 0), b2, voffB);
            PG8_BAR; PG8_WAIT_L(0); PG8_MMA(0, 1, At, B1); PG8_BAR;
            PG8_LDA(At, 0, 1); PG8_STAGE(PG8_SA(0, 0), a2, voffA);
            PG8_BAR; PG8_WAIT_L(0); PG8_MMA(1, 0, At, B0); PG8_BAR; PG8_SCHED;
            PG8_STAGE(PG8_SB(0, 1), b2 + hstepB, voffB);
            PG8_WAIT_V(6); PG8_BAR; PG8_MMA(1, 1, At, B1); PG8_BAR;
            PG8_LDB(B0, 1, 0); PG8_SCHED; PG8_LDA(At, 1, 0); PG8_STAGE(PG8_SA(0, 1), a2 + hstepA, voffA);
            PG8_WAIT_L(8); PG8_BAR; PG8_WAIT_L(0); PG8_MMA(0, 0, At, B0); PG8_BAR; PG8_SCHED;
            PG8_LDB(B1, 1, 1); PG8_STAGE(PG8_SB(1, 0), b3, voffB);
            PG8_BAR; PG8_WAIT_L(0); PG8_MMA(0, 1, At, B1); PG8_BAR;
            PG8_LDA(At, 1, 1); PG8_STAGE(PG8_SA(1, 0), a3, voffA);
            PG8_BAR; PG8_WAIT_L(0); PG8_MMA(1, 0, At, B0); PG8_BAR; PG8_SCHED;
            PG8_STAGE(PG8_SB(1, 1), b3 + hstepB, voffB);
            PG8_WAIT_V(6); PG8_BAR; PG8_MMA(1, 1, At, B1); PG8_BAR;
            }
        }
        if constexpr (ALIGN_EPI) { if (wr == 0) PG8_BAR; }
        if constexpr (!Epi::AFTER_DRAIN) { E(acc, cur, wr, wc, fr, fq); S.done(cur); }
        if (!has_next) break;
#pragma unroll
        for (int a = 0; a < 2; ++a)
#pragma unroll
            for (int b = 0; b < 2; ++b)
#pragma unroll
                for (int m = 0; m < 4; ++m)
#pragma unroll
                    for (int n = 0; n < 2; ++n) acc[a][b][m][n] = (f32x4){0.f, 0.f, 0.f, 0.f};
        cur = nxt; cA = nA; cB = nB; ++ui;
        if constexpr (ALIGN_EPI) { if (wr == 1) PG8_BAR; }
    }
    PG8_WAIT_V(0);
    if constexpr (!ALIGN_EPI) { if (wr == 0) PG8_BAR; }
    PG8_BAR;
    if constexpr (Epi::AFTER_DRAIN) { E.fused(acc, cur, wr, wc, fr, fq, lds, wid, lane); S.done(cur); }
#undef PG8_SA
#undef PG8_SB
#undef PG8_STAGE
#undef PG8_LDA
#undef PG8_LDB
#undef PG8_MMA
#undef PG8_WAIT_V
#undef PG8_WAIT_L
#undef PG8_BAR
#undef PG8_SCHED
}
}

#define LAS __attribute__((address_space(3)))
typedef unsigned short bf16;
typedef unsigned v4u __attribute__((ext_vector_type(4)));
typedef unsigned v2u __attribute__((ext_vector_type(2)));
typedef float f32x4 __attribute__((ext_vector_type(4)));
constexpr int NTHR = 512, NWAVES = 8;
constexpr int LDS_XB_OFF = 131072;
constexpr int LDS_BYTES = 147456;
constexpr size_t MiB = 1u << 20;
constexpr size_t WS_SSQ = 0;
constexpr size_t WS_LF = 1 * MiB;
constexpr size_t WS_BAR = 1 * MiB + 512 * 1024;
constexpr size_t WS_C_UNUSED = 1 * MiB + 768 * 1024;
constexpr size_t WS_XB = 2 * MiB;
constexpr size_t WS_W = 34 * MiB;
constexpr size_t W_IN = 0, W_P = (size_t)NIN * DM * 2, W_OUT = W_P + (size_t)3072 * 512 * 2, W_UP = W_OUT + (size_t)DM * DM * 2, W_DOWN = W_UP + (size_t)NUP * DM * 2, W_LAYER = W_DOWN + (size_t)DM * DFF * 2;
static_assert(W_LAYER == 37 * MiB, "weights per layer");
constexpr size_t WS_PA = WS_W + 4 * W_LAYER;
constexpr size_t WS_YG = WS_PA;
constexpr size_t WS_G = WS_PA + 144 * MiB;
constexpr size_t WS_MIX = WS_G + 96 * MiB;
constexpr size_t WS_U = WS_PA;
constexpr size_t WS_SG = WS_U, WS_SV = WS_U + 16 * MiB;
constexpr size_t WS_H = WS_U + 176 * MiB;
constexpr size_t WS_END = WS_MIX + 48 * MiB;
static_assert(WS_H + 88 * MiB <= WS_END, "ws map");

struct Params {
    const float* x; const float* norm1_g; const float* w_in; const float* fox_f_bias; const float* gate_bias; const float* conv_w;
    const float* fox_q_norm_g; const float* fox_k_norm_g; const float* w_proj_conv; const float* w_proj_fox; const float* w_proj_sb;
    const float* w_out; const float* norm2_g; const float* w_up; const float* ffn_conv_w; const float* ffn_conv_b; const float* w_down;
    float* out; unsigned char* ws;
};

__device__ __forceinline__ unsigned f2bf(float f) { unsigned u = __builtin_bit_cast(unsigned, f); return (u + 0x7fffu + ((u >> 16) & 1u)) >> 16; }
__device__ __forceinline__ unsigned pk2(float lo, float hi) { return f2bf(lo) | (f2bf(hi) << 16); }
__device__ __forceinline__ float blo(unsigned u) { return __uint_as_float(u << 16); }
__device__ __forceinline__ float bhi(unsigned u) { return __uint_as_float(u & 0xffff0000u); }
__device__ __forceinline__ float wave_sum(float v) {
#pragma unroll
    for (int o = 1; o < 64; o <<= 1) v += __shfl_xor(v, o);
    return v;
}
__device__ __forceinline__ void unpack8(const v4u w, float (&f)[8]) { f[0] = blo(w.x); f[1] = bhi(w.x); f[2] = blo(w.y); f[3] = bhi(w.y); f[4] = blo(w.z); f[5] = bhi(w.z); f[6] = blo(w.w); f[7] = bhi(w.w); }

__device__ __forceinline__ void tr_item(const float* W, int ldw, int scol, int nvalid, int ldk, const float* g, bf16* WT, int drow, int nblk, int item, LAS float* scr, int lane, int kofs = 0) {
    const int kb = item / nblk, nb = item % nblk, k0 = 64 * kb, n0 = 32 * nb;
    const int nn = n0 + (lane & 31); const bool ok = nn < nvalid;
    float tv[32];
    const float* src = W + (size_t)(k0 + (lane >> 5)) * ldw + scol + nn;
#pragma unroll
    for (int i = 0; i < 32; ++i) tv[i] = ok ? src[(size_t)(2 * i) * ldw] : 0.f;
    if (g) {
#pragma unroll
        for (int i = 0; i < 32; ++i) tv[i] *= g[k0 + 2 * i + (lane >> 5)];
    }
#pragma unroll
    for (int i = 0; i < 32; ++i) scr[(2 * i + (lane >> 5)) * 33 + (lane & 31)] = tv[i];
    asm volatile("s_waitcnt lgkmcnt(0)" ::: "memory");
    const int c = lane & 7;
#pragma unroll
    for (int j = 0; j < 4; ++j) { const int n = (lane >> 3) + 8 * j; const LAS float* s = scr + (8 * c) * 33 + n;
        v4u o; o.x = pk2(s[0 * 33], s[1 * 33]); o.y = pk2(s[2 * 33], s[3 * 33]); o.z = pk2(s[4 * 33], s[5 * 33]); o.w = pk2(s[6 * 33], s[7 * 33]);
        *(v4u*)(WT + (size_t)(drow + n0 + n) * ldk + kofs + k0 + 8 * c) = o; }
    asm volatile("s_waitcnt lgkmcnt(0)" ::: "memory");
}

__device__ __forceinline__ void prologue(const Params& p, LAS unsigned char* lds, int vcu, int G, int wave, int lane, int tid) {
    LAS float* scr = (LAS float*)(lds + wave * 16384);
    const int gw = vcu * NWAVES + wave, NGW = G * NWAVES;
    constexpr int I0 = 1536, I1 = I0 + 2304, I2 = I1 + 128, I3 = I2 + 768, I4 = I3 + 512, I5 = I4 + 2816, I6 = I5 + 1408;
    for (int it = gw; it < DEPTH * I6; it += NGW) {
        const int l = it / I6; int r = it % I6;
        unsigned char* wl = p.ws + WS_W + (size_t)l * W_LAYER;
        const float* win = p.w_in + (size_t)l * DM * DIN; const float* g1 = p.norm1_g + l * DM;
        if (r < I0) { tr_item(win, DIN, 0, 3072, DM, g1, (bf16*)(wl + W_IN), 0, 96, r, scr, lane); continue; }
        if (r < I1) { tr_item(win, DIN, 3080, 4608, DM, g1, (bf16*)(wl + W_IN), 3072, 144, r - I0, scr, lane); continue; }
        if (r < I2) { tr_item(win, DIN, 3072, 8, DM, g1, (bf16*)(wl + W_IN), 7680, 8, r - I1, scr, lane); continue; }
        if (r < I3) { r -= I2; const int b = r / 256; const float* wp = (b == 0 ? p.w_proj_conv : b == 1 ? p.w_proj_fox : p.w_proj_sb) + (size_t)l * 512 * DM;
                      tr_item(wp, DM, 0, DM, 1536, nullptr, (bf16*)(wl + W_P), 0, 32, r % 256, scr, lane, 512 * b); continue; }
        if (r < I4) { tr_item(p.w_out + (size_t)l * DM * DM, DM, 0, DM, DM, nullptr, (bf16*)(wl + W_OUT), 0, 32, r - I3, scr, lane); continue; }
        if (r < I5) { r -= I4; const int nb = r % 176, j = nb >> 3, q = nb & 7, src = (q < 4) ? 128 * j + 32 * q : DFF + 128 * j + 32 * (q - 4);
                      tr_item(p.w_up + (size_t)l * DM * NUP, NUP, src - 32 * nb, 1 << 30, DM, p.norm2_g + l * DM, (bf16*)(wl + W_UP), 0, 176, r, scr, lane); continue; }
        tr_item(p.w_down + (size_t)l * DFF * DM, DM, 0, DM, DFF, nullptr, (bf16*)(wl + W_DOWN), 0, 32, r - I5, scr, lane);
    }
    unsigned long long* ssq = (unsigned long long*)(p.ws + WS_SSQ); bf16* XB = (bf16*)(p.ws + WS_XB);
    for (int m = gw; m < MTOK; m += NGW) {
        const f32x4* xr = (const f32x4*)(p.x + (size_t)m * DM) + lane; v2u* xb = (v2u*)(XB + (size_t)m * DM) + lane;
        float s = 0.f;
#pragma unroll
        for (int j = 0; j < 4; ++j) { const f32x4 v = xr[64 * j]; v2u w; w.x = pk2(v.x, v.y); w.y = pk2(v.z, v.w); xb[64 * j] = w; s += (v.x * v.x + v.y * v.y) + (v.z * v.z + v.w * v.w); }
        s = wave_sum(s);
        if (lane == 0) ssq[m] = (unsigned long long)__float2ll_rn(s * SSQ_SCALE);
    }
    for (int i = vcu * NTHR + tid; i < 7 * MTOK; i += G * NTHR) ssq[MTOK + i] = 0ull;
}

__device__ __forceinline__ void conv_mixer(const bf16* PA, bf16* MIX, const float* cw, int vcu, int tid) {
    const int r0 = 64 * vcu + 8 * (tid >> 6), c0 = 8 * (tid & 63);
    float w0[8], w1[8], w2[8];
#pragma unroll
    for (int e = 0; e < 8; ++e) { w0[e] = cw[c0 + e]; w1[e] = cw[512 + c0 + e]; w2[e] = cw[1024 + c0 + e]; }
    float p2[8], p1[8];
#pragma unroll
    for (int e = 0; e < 8; ++e) { p2[e] = 0.f; p1[e] = 0.f; }
    const int tseq = r0 % SEQ;
    if (tseq >= 2) {
        float a[8], b[8];
        unpack8(*(const v4u*)(PA + (size_t)(r0 - 2) * PA_P + 512 + c0), a); unpack8(*(const v4u*)(PA + (size_t)(r0 - 2) * PA_P + 1024 + c0), b);
#pragma unroll
        for (int e = 0; e < 8; ++e) p2[e] = a[e] * b[e];
        unpack8(*(const v4u*)(PA + (size_t)(r0 - 1) * PA_P + 512 + c0), a); unpack8(*(const v4u*)(PA + (size_t)(r0 - 1) * PA_P + 1024 + c0), b);
#pragma unroll
        for (int e = 0; e < 8; ++e) p1[e] = a[e] * b[e];
    }
#pragma unroll
    for (int i = 0; i < 8; ++i) {
        const size_t ro = (size_t)(r0 + i) * PA_P;
        float gb[8], a[8], b[8], p0[8];
        unpack8(*(const v4u*)(PA + ro + c0), gb); unpack8(*(const v4u*)(PA + ro + 512 + c0), a); unpack8(*(const v4u*)(PA + ro + 1024 + c0), b);
        float y[8];
#pragma unroll
        for (int e = 0; e < 8; ++e) { p0[e] = a[e] * b[e]; y[e] = gb[e] * (w0[e] * p2[e] + w1[e] * p1[e] + w2[e] * p0[e]); p2[e] = p1[e]; p1[e] = p0[e]; }
        v4u o; o.x = pk2(y[0], y[1]); o.y = pk2(y[2], y[3]); o.z = pk2(y[4], y[5]); o.w = pk2(y[6], y[7]);
        *(v4u*)(MIX + (size_t)(r0 + i) * MIX_P + c0) = o;
    }
}

__device__ __forceinline__ void glu_fixup(const float* SG, const float* SV, bf16* H, const float* cw, const float* cb, int pm, int tid) {
    for (int idx = tid; idx < 8 * 352; idx += NTHR) {
        const int rr = idx / 352, cc = idx % 352, k = rr >> 1, i = rr & 1, c0 = 8 * cc, B = 4 * pm + k, row = 64 * B + i;
        const bool first = (B % (SEQ / 64)) == 0;
#pragma unroll
        for (int hf = 0; hf < 2; ++hf) { const int c = c0 + 4 * hf; const f32x4 z = (f32x4){0.f, 0.f, 0.f, 0.f};
            const f32x4 g0 = *(const f32x4*)(SG + ((size_t)B * 4 + 2 + i) * DFF + c);
            const f32x4 g1 = i ? *(const f32x4*)(SG + ((size_t)B * 4 + 2) * DFF + c) : (first ? z : *(const f32x4*)(SG + ((size_t)(B - 1) * 4 + 1) * DFF + c));
            const f32x4 g2 = first ? z : (i ? *(const f32x4*)(SG + ((size_t)(B - 1) * 4 + 1) * DFF + c) : *(const f32x4*)(SG + ((size_t)(B - 1) * 4 + 0) * DFF + c));
            const f32x4 v = *(const f32x4*)(SV + ((size_t)B * 2 + i) * DFF + c);
            const f32x4 w0 = *(const f32x4*)(cw + c), w1 = *(const f32x4*)(cw + DFF + c), w2 = *(const f32x4*)(cw + 2 * DFF + c), bb = *(const f32x4*)(cb + c);
            const f32x4 pre = w0 * g2 + w1 * g1 + w2 * g0 + bb; f32x4 hv;
#pragma unroll
            for (int e = 0; e < 4; ++e) hv[e] = pre[e] * __builtin_amdgcn_rcpf(1.0f + __builtin_amdgcn_exp2f(-LOG2E * pre[e])) * v[e];
            v2u w; w.x = pk2(hv[0], hv[1]); w.y = pk2(hv[2], hv[3]); *(v2u*)(H + (size_t)row * DFF + c) = w; }
    }
}

__device__ __forceinline__ void fox_scan(const float* LF, float* C, int bh, LAS float* sh, int tid, int wave, int lane) {
    const int b = bh >> 3, h = bh & 7;
    float v[4];
#pragma unroll
    for (int j = 0; j < 4; ++j) v[j] = LF[(size_t)(b * SEQ + 4 * tid + j) * 8 + h];
    v[1] += v[0]; v[2] += v[1]; v[3] += v[2];
    float tot = v[3];
#pragma unroll
    for (int o = 1; o < 64; o <<= 1) { const float n = __shfl_up(tot, o); if (lane >= o) tot += n; }
    if (lane == 63) sh[wave] = tot;
    __syncthreads();
    float base = tot - v[3];
    for (int w = 0; w < wave; ++w) base += sh[w];
#pragma unroll
    for (int j = 0; j < 4; ++j) C[(size_t)bh * SEQ + 4 * tid + j] = base + v[j];
    __syncthreads();
}

namespace att {
typedef float f32x16 __attribute__((ext_vector_type(16)));
typedef short bf16x8 __attribute__((ext_vector_type(8)));
typedef short s16x4 __attribute__((ext_vector_type(4)));
constexpr int KP = 144, VP = 136;
constexpr int KBUF = 64 * KP, VBUF = 64 * VP;
constexpr int OFF_K = 0, OFF_V = 2 * KBUF, OFF_C = OFF_V + 2 * VBUF, OFF_FLAG = OFF_C + SEQ * 4, OFF_SH = OFF_FLAG + 64;
static_assert(OFF_C % 16 == 0, "c array alignment");
__device__ __forceinline__ int crow(int r, int hi) { return (r & 3) + 8 * (r >> 2) + 4 * hi; }
__device__ __forceinline__ float dpp_xor1(float v) { return __int_as_float(__builtin_amdgcn_update_dpp(0, __float_as_int(v), 0xB1, 0xf, 0xf, true)); }
__device__ __forceinline__ float dpp_xor2(float v) { return __int_as_float(__builtin_amdgcn_update_dpp(0, __float_as_int(v), 0x4E, 0xf, 0xf, true)); }
__device__ __forceinline__ float dpp_hmir(float v) { return __int_as_float(__builtin_amdgcn_update_dpp(0, __float_as_int(v), 0x141, 0xf, 0xf, true)); }
__device__ __forceinline__ float xhalf(float v, int hi) { const unsigned u = __float_as_uint(v); auto rr = __builtin_amdgcn_permlane32_swap(u, u, false, false); return __uint_as_float(hi ? rr[0] : rr[1]); }
__device__ __forceinline__ unsigned pkbf(float lo, float hi) { unsigned r; asm volatile("v_cvt_pk_bf16_f32 %0, %1, %2" : "=v"(r) : "v"(lo), "v"(hi)); return r; }

__device__ __forceinline__ void scan_to_lds(const float* LF, int b, int h, LAS unsigned char* lds, int tid, int wave, int lane) {
    LAS float* cL = (LAS float*)(lds + OFF_C); LAS float* sh = (LAS float*)(lds + OFF_SH);
    float v[4];
#pragma unroll
    for (int j = 0; j < 4; ++j) v[j] = LF[(size_t)(b * SEQ + 4 * tid + j) * 8 + h];
    v[1] += v[0]; v[2] += v[1]; v[3] += v[2];
    float tot = v[3];
#pragma unroll
    for (int o = 1; o < 64; o <<= 1) { const float n = __shfl_up(tot, o); if (lane >= o) tot += n; }
    if (lane == 63) sh[wave] = tot;
    __syncthreads();
    float base = tot - v[3];
    for (int w = 0; w < wave; ++w) base += sh[w];
#pragma unroll
    for (int j = 0; j < 4; ++j) cL[4 * tid + j] = (base + v[j]) * LOG2E;
    __syncthreads();
}

template <int MODE>
__device__ __forceinline__ void attn_unit(LAS unsigned char* lds, const bf16* Qg, const bf16* Kg, const bf16* Vg, bf16* Og, int qt,
                                          const float* gq, const float* gk, int tid, int wave, int lane) {
    const int r32 = lane & 31, hi = lane >> 5;
    const int NT = 4 * qt + 4;
    const int qabs = 256 * qt + 32 * wave + r32;
    const int dtile = 4 * qt + (wave >> 1);
    const int srow = tid >> 3, sch = tid & 7;
    bf16x8 qr[4];
    { float qf[4][8]; float ss = 0.f;
#pragma unroll
      for (int d0 = 0; d0 < 4; ++d0) { unpack8(*(const v4u*)(Qg + (size_t)qabs * PA_P + 16 * d0 + 8 * hi), qf[d0]);
#pragma unroll
          for (int e = 0; e < 8; ++e) ss += qf[d0][e] * qf[d0][e]; }
      float sc = 0.125f * LOG2E;
      if (MODE == 0) { ss += __shfl_xor(ss, 32); sc *= rsqrtf(ss * (1.0f / 64.0f) + NORM_EPS); }
#pragma unroll
      for (int d0 = 0; d0 < 4; ++d0) { v4u w;
          if (MODE == 0) { float g[8];
#pragma unroll
              for (int e = 0; e < 8; ++e) g[e] = gq[16 * d0 + 8 * hi + e] * sc;
              w.x = pkbf(qf[d0][0] * g[0], qf[d0][1] * g[1]); w.y = pkbf(qf[d0][2] * g[2], qf[d0][3] * g[3]); w.z = pkbf(qf[d0][4] * g[4], qf[d0][5] * g[5]); w.w = pkbf(qf[d0][6] * g[6], qf[d0][7] * g[7]);
          } else { w.x = pkbf(qf[d0][0] * sc, qf[d0][1] * sc); w.y = pkbf(qf[d0][2] * sc, qf[d0][3] * sc); w.z = pkbf(qf[d0][4] * sc, qf[d0][5] * sc); w.w = pkbf(qf[d0][6] * sc, qf[d0][7] * sc); }
          qr[d0] = __builtin_bit_cast(bf16x8, w); } }
    float gkr[8];
#pragma unroll
    for (int e = 0; e < 8; ++e) gkr[e] = (MODE == 0) ? gk[8 * sch + e] : 1.0f;
    const LAS float* cL = (const LAS float*)(lds + OFF_C);
    const float cq = (MODE == 0) ? cL[qabs] : 0.f;
    f32x16 o[2];
#pragma unroll
    for (int r = 0; r < 16; ++r) { o[0][r] = 0.f; o[1][r] = 0.f; }
    float mrun = 0.f, lrun = 0.f, P = 1.0f;
    v4u kreg, vreg; bool sb_done = false;
#define ATT_GLOAD(T) do { const size_t ro_ = (size_t)(64 * (T) + srow) * PA_P + 8 * sch; kreg = *(const v4u*)(Kg + ro_); vreg = *(const v4u*)(Vg + ro_); } while (0)
#define ATT_STAGE(buf) do { \
        if (MODE == 0) { float kf_[8]; unpack8(kreg, kf_); float s_ = 0.f; _Pragma("unroll") for (int e = 0; e < 8; ++e) s_ += kf_[e] * kf_[e]; \
            s_ += dpp_xor1(s_); s_ += dpp_xor2(s_); s_ += dpp_hmir(s_); const float rs_ = rsqrtf(s_ * (1.0f / 64.0f) + NORM_EPS); \
            kreg.x = pkbf(kf_[0] * rs_ * gkr[0], kf_[1] * rs_ * gkr[1]); kreg.y = pkbf(kf_[2] * rs_ * gkr[2], kf_[3] * rs_ * gkr[3]); \
            kreg.z = pkbf(kf_[4] * rs_ * gkr[4], kf_[5] * rs_ * gkr[5]); kreg.w = pkbf(kf_[6] * rs_ * gkr[6], kf_[7] * rs_ * gkr[7]); } \
        *(LAS v4u*)(lds + OFF_K + (buf) * KBUF + srow * KP + sch * 16) = kreg; \
        LAS unsigned short* vt_ = (LAS unsigned short*)(lds + OFF_V + (buf) * VBUF + (8 * sch) * VP + srow * 2); \
        vt_[0 * (VP / 2)] = (unsigned short)(vreg.x & 0xffffu); vt_[1 * (VP / 2)] = (unsigned short)(vreg.x >> 16); \
        vt_[2 * (VP / 2)] = (unsigned short)(vreg.y & 0xffffu); vt_[3 * (VP / 2)] = (unsigned short)(vreg.y >> 16); \
        vt_[4 * (VP / 2)] = (unsigned short)(vreg.z & 0xffffu); vt_[5 * (VP / 2)] = (unsigned short)(vreg.z >> 16); \
        vt_[6 * (VP / 2)] = (unsigned short)(vreg.w & 0xffffu); vt_[7 * (VP / 2)] = (unsigned short)(vreg.w >> 16); } while (0)
    int it0 = 0;
    if (MODE == 0) { const float cq0 = cL[256 * qt]; while (it0 < 4 * qt && cq0 - cL[64 * it0 + 63] < -130.0f * LOG2E) ++it0; }
    ATT_GLOAD(MODE ? NT - 1 : it0);
    ATT_STAGE(0);
    __syncthreads();
    for (int it = it0; it < NT; ++it) {
        const int tile = MODE ? NT - 1 - it : it, buf = (it - it0) & 1;
        const bool more = it + 1 < NT;
        if (more) ATT_GLOAD(MODE ? tile - 1 : tile + 1);
        if (tile <= dtile && !(MODE == 1 && sb_done)) {
            const int kv0 = 64 * tile;
            f32x16 p0, p1;
            if (MODE == 0) { const float cqm = cq - mrun;
#pragma unroll
                for (int g = 0; g < 4; ++g) { const f32x4 c0 = *(const LAS f32x4*)(cL + kv0 + 8 * g + 4 * hi), c1 = *(const LAS f32x4*)(cL + kv0 + 32 + 8 * g + 4 * hi);
#pragma unroll
                    for (int j = 0; j < 4; ++j) { p0[4 * g + j] = cqm - c0[j]; p1[4 * g + j] = cqm - c1[j]; } }
            } else {
#pragma unroll
                for (int r = 0; r < 16; ++r) { p0[r] = 0.f; p1[r] = 0.f; }
            }
            const LAS unsigned char* kb = lds + OFF_K + buf * KBUF + r32 * KP + hi * 16;
            const LAS unsigned char* vb = lds + OFF_V + buf * VBUF + r32 * VP + hi * 8;
            bf16x8 kf[8];
#pragma unroll
            for (int d0 = 0; d0 < 4; ++d0) { kf[2 * d0] = *(const LAS bf16x8*)(kb + d0 * 32); kf[2 * d0 + 1] = *(const LAS bf16x8*)(kb + 32 * KP + d0 * 32); }
#pragma unroll
            for (int d0 = 0; d0 < 4; ++d0) {
                p0 = __builtin_amdgcn_mfma_f32_32x32x16_bf16(kf[2 * d0], qr[d0], p0, 0, 0, 0);
                p1 = __builtin_amdgcn_mfma_f32_32x32x16_bf16(kf[2 * d0 + 1], qr[d0], p1, 0, 0, 0);
            }
            s16x4 vlo[8], vhi[8];
#pragma unroll
            for (int db = 0; db < 2; ++db)
#pragma unroll
                for (int ks = 0; ks < 4; ++ks) { vlo[db * 4 + ks] = *(const LAS s16x4*)(vb + db * 32 * VP + ks * 32); vhi[db * 4 + ks] = *(const LAS s16x4*)(vb + db * 32 * VP + ks * 32 + 16); }
            const bool diag = (tile == dtile);
            if (MODE == 0) {
                if (diag) {
#pragma unroll
                    for (int r = 0; r < 16; ++r) { const int kv = kv0 + crow(r, hi); if (kv > qabs) p0[r] = -1e30f; if (kv + 32 > qabs) p1[r] = -1e30f; }
                }
                float mx = fmaxf(p0[0], p1[0]);
#pragma unroll
                for (int r = 1; r < 16; ++r) mx = fmaxf(mx, fmaxf(p0[r], p1[r]));
                mx = fmaxf(mx, xhalf(mx, hi));
                if (__any(mx > 8.0f)) {
                    const float dl = fmaxf(mx, 0.f), alpha = __builtin_amdgcn_exp2f(-dl);
                    mrun += dl; lrun *= alpha;
#pragma unroll
                    for (int r = 0; r < 16; ++r) { p0[r] -= dl; p1[r] -= dl; o[0][r] *= alpha; o[1][r] *= alpha; }
                }
                float ls = 0.f;
#pragma unroll
                for (int r = 0; r < 16; ++r) { p0[r] = __builtin_amdgcn_exp2f(p0[r]); p1[r] = __builtin_amdgcn_exp2f(p1[r]); ls += p0[r] + p1[r]; }
                lrun += ls;
            } else {
                float carry = P;
#pragma unroll
                for (int blk = 1; blk >= 0; --blk) {
                    f32x16& pz = blk ? p1 : p0;
                    float u[16], x[16];
#pragma unroll
                    for (int r = 0; r < 16; ++r) { u[r] = __builtin_amdgcn_exp2f(fminf(pz[r], 115.0f)); x[r] = 1.0f + u[r]; }
                    if (diag) {
#pragma unroll
                        for (int r = 0; r < 16; ++r) { const bool act = (kv0 + 32 * blk + crow(r, hi)) < qabs; u[r] = act ? u[r] : 0.f; x[r] = act ? x[r] : 1.0f; }
                    }
                    float s[16], Gown[4], Gp[4], AP[4], AG[4];
#pragma unroll
                    for (int g = 0; g < 4; ++g) { s[4 * g + 3] = 1.0f; s[4 * g + 2] = x[4 * g + 3]; s[4 * g + 1] = s[4 * g + 2] * x[4 * g + 2]; s[4 * g] = s[4 * g + 1] * x[4 * g + 1]; Gown[g] = s[4 * g] * x[4 * g]; }
#pragma unroll
                    for (int g = 0; g < 4; ++g) Gp[g] = xhalf(Gown[g], hi);
                    AP[3] = carry; AP[2] = AP[3] * (Gown[3] * Gp[3]); AP[1] = AP[2] * (Gown[2] * Gp[2]); AP[0] = AP[1] * (Gown[1] * Gp[1]); carry = AP[0] * (Gown[0] * Gp[0]);
#pragma unroll
                    for (int g = 0; g < 4; ++g) AG[g] = hi ? AP[g] : AP[g] * Gp[g];
#pragma unroll
                    for (int r = 0; r < 16; ++r) pz[r] = u[r] * __builtin_amdgcn_rcpf(x[r] * (AG[r >> 2] * s[r]));
                }
                P = carry;
            }
            bf16x8 pb[4];
#pragma unroll
            for (int ks = 0; ks < 4; ++ks) { const f32x16& pz = (ks >> 1) ? p1 : p0; const int rb = 8 * (ks & 1);
                v4u w; w.x = pkbf(pz[rb + 0], pz[rb + 1]); w.y = pkbf(pz[rb + 2], pz[rb + 3]); w.z = pkbf(pz[rb + 4], pz[rb + 5]); w.w = pkbf(pz[rb + 6], pz[rb + 7]);
                pb[ks] = __builtin_bit_cast(bf16x8, w); }
#pragma unroll
            for (int ks = 0; ks < 4; ++ks)
#pragma unroll
                for (int db = 0; db < 2; ++db) {
                    const s16x4 lo = vlo[db * 4 + ks], hh = vhi[db * 4 + ks];
                    const bf16x8 a = (bf16x8){lo[0], lo[1], lo[2], lo[3], hh[0], hh[1], hh[2], hh[3]};
                    o[db] = __builtin_amdgcn_mfma_f32_32x32x16_bf16(a, pb[ks], o[db], 0, 0, 0);
                }
        }
        if (more) ATT_STAGE(buf ^ 1);
        if (MODE == 1) { const int dn_ = __all(P > 8.0e37f) ? 1 : 0; sb_done = dn_ != 0; if (lane == 0) ((LAS int*)(lds + OFF_FLAG))[(it & 1) * 8 + wave] = dn_; }
        __syncthreads();
        if (MODE == 1) { const LAS int* fl = (const LAS int*)(lds + OFF_FLAG) + (it & 1) * 8; int dn = 1;
#pragma unroll
            for (int w = 0; w < 8; ++w) dn &= fl[w];
            if (dn) break; }
    }
#undef ATT_GLOAD
#undef ATT_STAGE
    float inv = 1.0f;
    if (MODE == 0) { const float lt = lrun + __shfl_xor(lrun, 32); inv = 1.0f / lt; }
    bf16* orow = Og + (size_t)qabs * MIX_P;
#pragma unroll
    for (int db = 0; db < 2; ++db)
#pragma unroll
        for (int g = 0; g < 4; ++g) { v2u w; w.x = pkbf(o[db][4 * g] * inv, o[db][4 * g + 1] * inv); w.y = pkbf(o[db][4 * g + 2] * inv, o[db][4 * g + 3] * inv);
            *(v2u*)(orow + 32 * db + 8 * g + 4 * hi) = w; }
}

struct FoxState { bf16x8 qr0, qr1, qr2, qr3; f32x16 o0, o1; float cq, mrun, lrun; int qabs, dtile, it0; };
__device__ __forceinline__ void fox_setup(FoxState& s, const bf16* Qg, int qt, const float* gq, const LAS float* cL, int wave, int r32, int hi) {
    s.qabs = 256 * qt + 32 * wave + r32; s.dtile = 4 * qt + (wave >> 1);
    int it0 = 0; { const float cq0 = cL[256 * qt]; while (it0 < 4 * qt && cq0 - cL[64 * it0 + 63] < -130.0f * LOG2E) ++it0; }
    s.it0 = it0;
    float qf[4][8]; float ss = 0.f;
#pragma unroll
    for (int d0 = 0; d0 < 4; ++d0) { unpack8(*(const v4u*)(Qg + (size_t)s.qabs * PA_P + 16 * d0 + 8 * hi), qf[d0]);
#pragma unroll
        for (int e = 0; e < 8; ++e) ss += qf[d0][e] * qf[d0][e]; }
    ss += __shfl_xor(ss, 32);
    const float sc = 0.125f * LOG2E * rsqrtf(ss * (1.0f / 64.0f) + NORM_EPS);
    bf16x8 q[4];
#pragma unroll
    for (int d0 = 0; d0 < 4; ++d0) { float g[8];
#pragma unroll
        for (int e = 0; e < 8; ++e) g[e] = gq[16 * d0 + 8 * hi + e] * sc;
        v4u w; w.x = pkbf(qf[d0][0] * g[0], qf[d0][1] * g[1]); w.y = pkbf(qf[d0][2] * g[2], qf[d0][3] * g[3]); w.z = pkbf(qf[d0][4] * g[4], qf[d0][5] * g[5]); w.w = pkbf(qf[d0][6] * g[6], qf[d0][7] * g[7]);
        q[d0] = __builtin_bit_cast(bf16x8, w); }
    s.qr0 = q[0]; s.qr1 = q[1]; s.qr2 = q[2]; s.qr3 = q[3];
    s.cq = cL[s.qabs]; s.mrun = 0.f; s.lrun = 0.f;
#pragma unroll
    for (int r = 0; r < 16; ++r) { s.o0[r] = 0.f; s.o1[r] = 0.f; }
}
__device__ __forceinline__ void fox_tile(FoxState& s, LAS unsigned char* lds, const LAS float* cL, int tile, int buf, int r32, int hi) {
    const int kv0 = 64 * tile;
    f32x16 p0, p1;
    { const float cqm = s.cq - s.mrun;
#pragma unroll
      for (int g = 0; g < 4; ++g) { const f32x4 c0 = *(const LAS f32x4*)(cL + kv0 + 8 * g + 4 * hi), c1 = *(const LAS f32x4*)(cL + kv0 + 32 + 8 * g + 4 * hi);
#pragma unroll
          for (int j = 0; j < 4; ++j) { p0[4 * g + j] = cqm - c0[j]; p1[4 * g + j] = cqm - c1[j]; } } }
    const LAS unsigned char* kb = lds + OFF_K + buf * KBUF + r32 * KP + hi * 16;
    const LAS unsigned char* vb = lds + OFF_V + buf * VBUF + r32 * VP + hi * 8;
    bf16x8 kf[8];
#pragma unroll
    for (int d0 = 0; d0 < 4; ++d0) { kf[2 * d0] = *(const LAS bf16x8*)(kb + d0 * 32); kf[2 * d0 + 1] = *(const LAS bf16x8*)(kb + 32 * KP + d0 * 32); }
    p0 = __builtin_amdgcn_mfma_f32_32x32x16_bf16(kf[0], s.qr0, p0, 0, 0, 0); p1 = __builtin_amdgcn_mfma_f32_32x32x16_bf16(kf[1], s.qr0, p1, 0, 0, 0);
    p0 = __builtin_amdgcn_mfma_f32_32x32x16_bf16(kf[2], s.qr1, p0, 0, 0, 0); p1 = __builtin_amdgcn_mfma_f32_32x32x16_bf16(kf[3], s.qr1, p1, 0, 0, 0);
    p0 = __builtin_amdgcn_mfma_f32_32x32x16_bf16(kf[4], s.qr2, p0, 0, 0, 0); p1 = __builtin_amdgcn_mfma_f32_32x32x16_bf16(kf[5], s.qr2, p1, 0, 0, 0);
    p0 = __builtin_amdgcn_mfma_f32_32x32x16_bf16(kf[6], s.qr3, p0, 0, 0, 0); p1 = __builtin_amdgcn_mfma_f32_32x32x16_bf16(kf[7], s.qr3, p1, 0, 0, 0);
    s16x4 vlo[8], vhi[8];
#pragma unroll
    for (int db = 0; db < 2; ++db)
#pragma unroll
        for (int ks = 0; ks < 4; ++ks) { vlo[db * 4 + ks] = *(const LAS s16x4*)(vb + db * 32 * VP + ks * 32); vhi[db * 4 + ks] = *(const LAS s16x4*)(vb + db * 32 * VP + ks * 32 + 16); }
    if (tile == s.dtile) {
#pragma unroll
        for (int r = 0; r < 16; ++r) { const int kv = kv0 + crow(r, hi); if (kv > s.qabs) p0[r] = -1e30f; if (kv + 32 > s.qabs) p1[r] = -1e30f; }
    }
    float mx = fmaxf(p0[0], p1[0]);
#pragma unroll
    for (int r = 1; r < 16; ++r) mx = fmaxf(mx, fmaxf(p0[r], p1[r]));
    mx = fmaxf(mx, xhalf(mx, hi));
    if (__any(mx > 8.0f)) {
        const float dl = fmaxf(mx, 0.f), alpha = __builtin_amdgcn_exp2f(-dl);
        s.mrun += dl; s.lrun *= alpha;
#pragma unroll
        for (int r = 0; r < 16; ++r) { p0[r] -= dl; p1[r] -= dl; s.o0[r] *= alpha; s.o1[r] *= alpha; }
    }
    float ls = 0.f;
#pragma unroll
    for (int r = 0; r < 16; ++r) { p0[r] = __builtin_amdgcn_exp2f(p0[r]); p1[r] = __builtin_amdgcn_exp2f(p1[r]); ls += p0[r] + p1[r]; }
    s.lrun += ls;
    bf16x8 pb[4];
#pragma unroll
    for (int ks = 0; ks < 4; ++ks) { const f32x16& pz = (ks >> 1) ? p1 : p0; const int rb = 8 * (ks & 1);
        v4u w; w.x = pkbf(pz[rb + 0], pz[rb + 1]); w.y = pkbf(pz[rb + 2], pz[rb + 3]); w.z = pkbf(pz[rb + 4], pz[rb + 5]); w.w = pkbf(pz[rb + 6], pz[rb + 7]);
        pb[ks] = __builtin_bit_cast(bf16x8, w); }
#pragma unroll
    for (int ks = 0; ks < 4; ++ks) {
        { const s16x4 lo = vlo[ks], hh = vhi[ks]; const bf16x8 a = (bf16x8){lo[0], lo[1], lo[2], lo[3], hh[0], hh[1], hh[2], hh[3]}; s.o0 = __builtin_amdgcn_mfma_f32_32x32x16_bf16(a, pb[ks], s.o0, 0, 0, 0); }
        { const s16x4 lo = vlo[4 + ks], hh = vhi[4 + ks]; const bf16x8 a = (bf16x8){lo[0], lo[1], lo[2], lo[3], hh[0], hh[1], hh[2], hh[3]}; s.o1 = __builtin_amdgcn_mfma_f32_32x32x16_bf16(a, pb[ks], s.o1, 0, 0, 0); }
    }
}
__device__ __forceinline__ void fox_store(const FoxState& s, bf16* Og, int hi) {
    const float lt = s.lrun + __shfl_xor(s.lrun, 32), inv = 1.0f / lt;
    bf16* orow = Og + (size_t)s.qabs * MIX_P;
#pragma unroll
    for (int g = 0; g < 4; ++g) { v2u w; w.x = pkbf(s.o0[4 * g] * inv, s.o0[4 * g + 1] * inv); w.y = pkbf(s.o0[4 * g + 2] * inv, s.o0[4 * g + 3] * inv); *(v2u*)(orow + 8 * g + 4 * hi) = w; }
#pragma unroll
    for (int g = 0; g < 4; ++g) { v2u w; w.x = pkbf(s.o1[4 * g] * inv, s.o1[4 * g + 1] * inv); w.y = pkbf(s.o1[4 * g + 2] * inv, s.o1[4 * g + 3] * inv); *(v2u*)(orow + 32 + 8 * g + 4 * hi) = w; }
}
__device__ __forceinline__ void fox_pair(LAS unsigned char* lds, const bf16* Qg, const bf16* Kg, const bf16* Vg, bf16* Og, int qtA, int qtB,
                                         const float* gq, const float* gk, int tid, int wave, int lane) {
    const int r32 = lane & 31, hi = lane >> 5, srow = tid >> 3, sch = tid & 7;
    const LAS float* cL = (const LAS float*)(lds + OFF_C);
    FoxState A, B;
    int itA0 = 0; { const float cq0 = cL[256 * qtA]; while (itA0 < 4 * qtA && cq0 - cL[64 * itA0 + 63] < -130.0f * LOG2E) ++itA0; }
    v4u kreg, vreg;
    { const size_t ro_ = (size_t)(64 * itA0 + srow) * PA_P + 8 * sch; kreg = *(const v4u*)(Kg + ro_); vreg = *(const v4u*)(Vg + ro_); }
    fox_setup(A, Qg, qtA, gq, cL, wave, r32, hi);
    fox_setup(B, Qg, qtB, gq, cL, wave, r32, hi);
    const int lastA = 4 * qtA + 3, lastB = 4 * qtB + 3;
    const int jump = (B.it0 > lastA + 1) ? B.it0 : lastA + 1;
    float gkr[8];
#pragma unroll
    for (int e = 0; e < 8; ++e) gkr[e] = gk[8 * sch + e];
#define FP_GLOAD(T) do { const size_t ro_ = (size_t)(64 * (T) + srow) * PA_P + 8 * sch; kreg = *(const v4u*)(Kg + ro_); vreg = *(const v4u*)(Vg + ro_); } while (0)
#define FP_STAGE(buf) do { \
        float kf_[8]; unpack8(kreg, kf_); float s_ = 0.f; _Pragma("unroll") for (int e = 0; e < 8; ++e) s_ += kf_[e] * kf_[e]; \
        s_ += dpp_xor1(s_); s_ += dpp_xor2(s_); s_ += dpp_hmir(s_); const float rs_ = rsqrtf(s_ * (1.0f / 64.0f) + NORM_EPS); \
        v4u kn_; kn_.x = pkbf(kf_[0] * rs_ * gkr[0], kf_[1] * rs_ * gkr[1]); kn_.y = pkbf(kf_[2] * rs_ * gkr[2], kf_[3] * rs_ * gkr[3]); \
        kn_.z = pkbf(kf_[4] * rs_ * gkr[4], kf_[5] * rs_ * gkr[5]); kn_.w = pkbf(kf_[6] * rs_ * gkr[6], kf_[7] * rs_ * gkr[7]); \
        *(LAS v4u*)(lds + OFF_K + (buf) * KBUF + srow * KP + sch * 16) = kn_; \
        LAS unsigned short* vt_ = (LAS unsigned short*)(lds + OFF_V + (buf) * VBUF + (8 * sch) * VP + srow * 2); \
        vt_[0 * (VP / 2)] = (unsigned short)(vreg.x & 0xffffu); vt_[1 * (VP / 2)] = (unsigned short)(vreg.x >> 16); \
        vt_[2 * (VP / 2)] = (unsigned short)(vreg.y & 0xffffu); vt_[3 * (VP / 2)] = (unsigned short)(vreg.y >> 16); \
        vt_[4 * (VP / 2)] = (unsigned short)(vreg.z & 0xffffu); vt_[5 * (VP / 2)] = (unsigned short)(vreg.z >> 16); \
        vt_[6 * (VP / 2)] = (unsigned short)(vreg.w & 0xffffu); vt_[7 * (VP / 2)] = (unsigned short)(vreg.w >> 16); } while (0)
    int t = A.it0, buf = 0;
    FP_STAGE(0);
    __syncthreads();
    while (t <= lastB) {
        const int tn = (t == lastA) ? jump : t + 1;
        const bool more = tn <= lastB;
        if (more) FP_GLOAD(tn);
        if (t <= A.dtile) fox_tile(A, lds, cL, t, buf, r32, hi);
        if (t >= B.it0 && t <= B.dtile) fox_tile(B, lds, cL, t, buf, r32, hi);
        if (more) FP_STAGE(buf ^ 1);
        __syncthreads();
        t = tn; buf ^= 1;
    }
#undef FP_GLOAD
#undef FP_STAGE
    fox_store(A, Og, hi); fox_store(B, Og, hi);
}
}

#define XB_TMO      128
#define XB_XCNT(j)  (256  + 64 * (j))
#define XB_XSUB(j)  (1280 + 64 * (j))
#define XB_XGEN(j)  (2304 + 64 * (j))
#define XB_TOP      3328
#define XB_TOPGEN   3392
#define XCD_BAR_WORDS 3456
#define XB_SPIN_CAP (1u << 18)

__device__ __forceinline__ unsigned xb_ld(unsigned* p)              { return __hip_atomic_load(p, __ATOMIC_RELAXED, __HIP_MEMORY_SCOPE_AGENT); }
__device__ __forceinline__ unsigned xb_add(unsigned* p, unsigned v) { return __hip_atomic_fetch_add(p, v, __ATOMIC_RELAXED, __HIP_MEMORY_SCOPE_AGENT); }
__device__ __forceinline__ unsigned xb_xcc_id() { return (unsigned)__builtin_amdgcn_s_getreg((3 << 11) | 20) & 0xFu; }
#define XB_SPIN(cond, bar) do { unsigned _sp = 0; while (cond) { __builtin_amdgcn_s_sleep(1); \
    if ((++_sp & 255u) == 0u) { if (xb_ld(&(bar)[XB_TMO])) break; if (_sp > XB_SPIN_CAP) { atomicAdd(&(bar)[XB_TMO], 1u); break; } } } } while (0)

struct XcdBarrier {
    unsigned* bar; unsigned x;
    volatile LAS unsigned* st;
};

__device__ __forceinline__ XcdBarrier xcd_barrier_post(unsigned* bar, volatile LAS unsigned* st) {
    XcdBarrier b; b.bar = bar; b.x = xb_xcc_id(); b.st = st;
    if (threadIdx.x == 0) (void)xb_add(&bar[XB_XCNT(b.x)], 1u);
    return b;
}
__device__ __forceinline__ void xcd_barrier_complete(unsigned* bar, unsigned x, unsigned& nloc, unsigned& nx) {
    const unsigned G = gridDim.x * gridDim.y * gridDim.z;
    unsigned sum, cnt, mine, sp = 0u;
    for (;;) {
        sum = 0u; cnt = 0u; mine = 0u;
#pragma unroll
        for (unsigned j = 0; j < 16; ++j) { const unsigned c = xb_ld(&bar[XB_XCNT(j)]); sum += c; cnt += (c > 0u) ? 1u : 0u; mine = (j == x) ? c : mine; }
        if (sum == G) break;
        __builtin_amdgcn_s_sleep(1);
        if ((++sp & 255u) == 0u) { if (xb_ld(&bar[XB_TMO])) break; if (sp > XB_SPIN_CAP) { atomicAdd(&bar[XB_TMO], 1u); break; } }
    }
    nloc = mine > 0u ? mine : 1u; nx = cnt > 0u ? cnt : 1u;
}

__device__ __forceinline__ void xcd_barrier(const XcdBarrier& b) {
    asm volatile("s_waitcnt vmcnt(0)" ::: "memory");
    __syncthreads();
    if (threadIdx.x == 0) {
        unsigned* bar = b.bar; unsigned bxx = b.x; asm volatile("" : "+s"(bar), "+s"(bxx));
        __builtin_amdgcn_s_waitcnt(0);
        unsigned nloc = b.st[0], nx = b.st[1];
        if (nloc == 0u) { xcd_barrier_complete(bar, bxx, nloc, nx); b.st[0] = nloc; b.st[1] = nx; }
        const unsigned old = xb_add(&bar[XB_XSUB(bxx)], 1u);
        const unsigned gen = old / nloc;
        if (old + 1u == (gen + 1u) * nloc) {
            __builtin_amdgcn_fence(__ATOMIC_RELEASE, "agent");
            asm volatile("s_waitcnt vmcnt(0)" ::: "memory");
            const unsigned og = xb_add(&bar[XB_TOP], 1u);
            const unsigned tg = og / nx;
            if (og + 1u == (tg + 1u) * nx) xb_add(&bar[XB_TOPGEN], 1u);
            else XB_SPIN(xb_ld(&bar[XB_TOPGEN]) == tg, bar);
            __builtin_amdgcn_fence(__ATOMIC_ACQUIRE, "agent");
            xb_add(&bar[XB_XGEN(bxx)], 1u);
            asm volatile("s_waitcnt vmcnt(0)" ::: "memory");
        } else {
            XB_SPIN(xb_ld(&bar[XB_XGEN(bxx)]) == gen, bar);
            __builtin_amdgcn_fence(__ATOMIC_ACQUIRE, "agent");
            asm volatile("s_waitcnt vmcnt(0)" ::: "memory");
        }
    }
    __syncthreads();
}

#define CW_XT    4096
#define CW_FLAG  4608
#define CW_LOC(x) (5120 + 64 * (x))
#define CTL_MEMSET_BYTES 32768
__device__ __forceinline__ void xcd_local_barrier(unsigned* ctl, int grp, unsigned& lgen, const bool is_t0) {
    asm volatile("s_waitcnt vmcnt(0) lgkmcnt(0)" ::: "memory");
    __syncthreads();
    if (is_t0) {
        asm volatile("" : "+s"(ctl));
        unsigned* cnt = ctl + CW_LOC(grp);
        (void)xb_add(cnt, 1u);
        const unsigned target = (lgen + 1u) * 32u;
        XB_SPIN(xb_ld(cnt) < target, ctl);
        __builtin_amdgcn_fence(__ATOMIC_ACQUIRE, "agent");
        asm volatile("s_waitcnt vmcnt(0)" ::: "memory");
    }
    lgen += 1u;
    __syncthreads();
}

__device__ __forceinline__ const Params* kargs() { const Params* q = (const Params*)__builtin_amdgcn_kernarg_segment_ptr(); asm volatile("" : "+s"(q)); return q; }
#define WSP(T, off) ((T*)(P->ws + (off)))
#define CGSYNC() do { asm volatile("s_waitcnt vmcnt(0) lgkmcnt(0)" ::: "memory"); __syncthreads(); \
    if (wave == 0) { __builtin_amdgcn_fence(__ATOMIC_RELEASE, "agent"); asm volatile("s_waitcnt vmcnt(0)" ::: "memory"); } \
    cg::this_grid().sync(); \
    if (wave == 0) { __builtin_amdgcn_fence(__ATOMIC_ACQUIRE, "agent"); asm volatile("s_waitcnt vmcnt(0)" ::: "memory"); } \
    __syncthreads(); } while (0)
#define GSYNC_GLOBAL() do { asm volatile("s_waitcnt lgkmcnt(0)" ::: "memory"); xcd_barrier(xbar); } while (0)
#define GSYNC() do { if (loc_mode) xcd_local_barrier(ctlw, bx & 7, lgen, threadIdx.x == 0); else GSYNC_GLOBAL(); } while (0)
__global__ void __launch_bounds__(NTHR, 2) fwd_megakernel(Params p_arg) {
    extern __shared__ __attribute__((aligned(16))) unsigned char lds_raw[];
    LAS unsigned char* lds = (LAS unsigned char*)lds_raw;
    const int tid = threadIdx.x, lane = tid & 63, wave = __builtin_amdgcn_readfirstlane(tid >> 6);
    const int G = gridDim.x, bx = blockIdx.x;
    const int vcu = (G % 8 == 0) ? (bx % 8) * (G / 8) + bx / 8 : bx;

    volatile LAS unsigned* xst = (volatile LAS unsigned*)(lds + LDS_XB_OFF);
    if (tid < 4) xst[tid] = 0u;
    __syncthreads();
    const XcdBarrier xbar = xcd_barrier_post((unsigned*)(p_arg.ws + WS_BAR), xst);
    unsigned* ctlw = (unsigned*)(p_arg.ws + WS_BAR);
    if (tid == 0) __hip_atomic_store(ctlw + CW_XT + bx, xbar.x + 1u, __ATOMIC_RELAXED, __HIP_MEMORY_SCOPE_AGENT);
    { const Params* P = &p_arg; prologue(*P, lds, vcu, G, wave, lane, tid); }
    if (p_arg.ws == nullptr) CGSYNC();
    GSYNC_GLOBAL();
    if (wave == 0) { bool bad = false;
        if (G == 256) { if (lane < 32) bad = __hip_atomic_load(ctlw + CW_XT + (bx & 7) + 8 * lane, __ATOMIC_RELAXED, __HIP_MEMORY_SCOPE_AGENT) != xbar.x + 1u; } else bad = true;
        if (__any(bad) && lane == 0) (void)xb_add(ctlw + CW_FLAG, 1u); }
    GSYNC_GLOBAL();
    const bool loc_mode = __builtin_amdgcn_readfirstlane((int)__hip_atomic_load(ctlw + CW_FLAG, __ATOMIC_RELAXED, __HIP_MEMORY_SCOPE_AGENT)) == 0;
    unsigned lgen = 0u;

#pragma unroll 1
    for (int l = 0; l < DEPTH; ++l) {
        { const Params* P = &p_arg; const unsigned char* wl = P->ws + WS_W + (size_t)l * W_LAYER;
          pg8::Gemm g{WSP(bf16, WS_XB), (const bf16*)(wl + W_IN), MTOK, NIN, DM, DM, DM, 1 << 20, 0, 16}; pg8::StaticOrder S; S.init(MTOK, NIN, G, bx);
          pg8::EpiIn E{WSP(bf16, WS_PA), WSP(bf16, WS_G), WSP(float, WS_LF), WSP(unsigned long long, WS_SSQ) + (size_t)(2 * l) * MTOK, P->gate_bias + l * 3072, P->fox_f_bias + l * 8};
          pg8::gemm_phase<pg8::EpiIn, pg8::StaticOrder, true, true>(lds, g, S, E); }
        GSYNC();
        { const Params* P = &p_arg; int tid = threadIdx.x; asm volatile("" : "+v"(tid)); const int lane = tid & 63;
          for (int v = vcu; v < MTOK / 64; v += G) conv_mixer(WSP(bf16, WS_PA), WSP(bf16, WS_MIX), P->conv_w + l * 1536, v, tid);
#pragma unroll 1
          for (int wv = vcu; wv < 256; wv += G) {
            const int bh = wv >> 2, pr = wv & 3, b = bh >> 3, h = bh & 7;
            att::scan_to_lds(WSP(float, WS_LF), b, h, lds, tid, wave, lane);
            const bf16* PAb = WSP(bf16, WS_PA) + (size_t)b * SEQ * PA_P + h * 64; bf16* MIXb = WSP(bf16, WS_MIX) + (size_t)b * SEQ * MIX_P + h * 64;
            att::fox_pair(lds, PAb + 1536, PAb + 2048, PAb + 2560, MIXb + 512, pr, 7 - pr, P->fox_q_norm_g + l * 64, P->fox_k_norm_g + l * 64, tid, wave, lane);
#pragma unroll 1
            for (int k = 0; k < 2; ++k) att::attn_unit<1>(lds, PAb + 3072, PAb + 3584, PAb + 4096, MIXb + 1024, 2 * (3 - pr) + k, nullptr, nullptr, tid, wave, lane);
          } }
        GSYNC();
        { const Params* P = &p_arg; const unsigned char* wl = P->ws + WS_W + (size_t)l * W_LAYER;
          pg8::Gemm g{WSP(bf16, WS_MIX), (const bf16*)(wl + W_P), MTOK, DM, 1536, MIX_P, 1536, 1 << 20, 0, 24}; pg8::StaticOrder S; S.init(MTOK, DM, G, bx);
          pg8::EpiMerge E{WSP(bf16, WS_YG), WSP(bf16, WS_G)};
          pg8::gemm_phase<pg8::EpiMerge, pg8::StaticOrder, true, true>(lds, g, S, E); }
        GSYNC();
        { const Params* P = &p_arg; const unsigned char* wl = P->ws + WS_W + (size_t)l * W_LAYER;
          pg8::Gemm g{WSP(bf16, WS_YG), (const bf16*)(wl + W_OUT), MTOK, DM, DM, DM, DM, 1 << 20, 0, 16}; pg8::StaticOrder S; S.init(MTOK, DM, G, bx);
          pg8::EpiRes E{l == 0 ? P->x : P->out, P->out, WSP(bf16, WS_XB), WSP(unsigned long long, WS_SSQ) + (size_t)(2 * l + 1) * MTOK};
          pg8::gemm_phase<pg8::EpiRes, pg8::StaticOrder, true, true>(lds, g, S, E); }
        GSYNC();
        { const Params* P = &p_arg; const unsigned char* wl = P->ws + WS_W + (size_t)l * W_LAYER;
          pg8::Gemm g{WSP(bf16, WS_XB), (const bf16*)(wl + W_UP), MTOK, NUP, DM, DM, DM, 1 << 20, 0, 16}; pg8::StaticOrder S; S.init(MTOK, NUP, G, bx);
          pg8::EpiGlu E{WSP(bf16, WS_H), WSP(float, WS_SG), WSP(float, WS_SV), WSP(unsigned long long, WS_SSQ) + (size_t)(2 * l + 1) * MTOK, P->ffn_conv_w + l * 3 * DFF, P->ffn_conv_b + l * DFF};
          pg8::gemm_phase<pg8::EpiGlu, pg8::StaticOrder, true, true>(lds, g, S, E); }
        GSYNC();
        { const Params* P = &p_arg; const unsigned char* wl = P->ws + WS_W + (size_t)l * W_LAYER;
          pg8::Gemm g{WSP(bf16, WS_H), (const bf16*)(wl + W_DOWN), MTOK, DM, DFF, DFF, DFF, 1 << 20, 0, 44}; pg8::StaticOrder S; S.init(MTOK, DM, G, bx);
          { int tid = threadIdx.x; asm volatile("" : "+v"(tid)); pg8::Unit u;
            for (int i = 0; S.next(i, u); ++i) glu_fixup(WSP(float, WS_SG), WSP(float, WS_SV), WSP(bf16, WS_H), P->ffn_conv_w + l * 3 * DFF, P->ffn_conv_b + l * DFF, u.pm, tid);
            asm volatile("s_waitcnt vmcnt(0)" ::: "memory"); __syncthreads(); }
          const bool lastl = (l == DEPTH - 1);
          pg8::EpiRes E{P->out, P->out, lastl ? nullptr : WSP(bf16, WS_XB), lastl ? nullptr : WSP(unsigned long long, WS_SSQ) + (size_t)(2 * l + 2) * MTOK};
          pg8::gemm_phase<pg8::EpiRes, pg8::StaticOrder, true, true>(lds, g, S, E); }
        GSYNC();
    }
}

extern "C" void kernel_launch(void* const* d_in, const int* in_sizes, int n_in, void* d_out, int out_size, void* d_ws, size_t ws_size, hipStream_t stream) {
    static int grid = 0;
    if (grid == 0) {
        int dev = 0, cus = 0, per_cu = 0;
        hipGetDevice(&dev);
        hipDeviceGetAttribute(&cus, hipDeviceAttributeMultiprocessorCount, dev);
        hipFuncSetAttribute((const void*)fwd_megakernel, hipFuncAttributeMaxDynamicSharedMemorySize, LDS_BYTES);
        hipOccupancyMaxActiveBlocksPerMultiprocessor(&per_cu, (const void*)fwd_megakernel, NTHR, LDS_BYTES);
        if (per_cu < 1) per_cu = 1;
        grid = cus * 1;
        if (ws_size < WS_END) fprintf(stderr, "kernel_launch: workspace too small (%zu < %zu)\n", ws_size, (size_t)WS_END);
    }
    Params p{};
    p.x = (const float*)d_in[0]; p.norm1_g = (const float*)d_in[1]; p.w_in = (const float*)d_in[2]; p.fox_f_bias = (const float*)d_in[3];
    p.gate_bias = (const float*)d_in[4]; p.conv_w = (const float*)d_in[5]; p.fox_q_norm_g = (const float*)d_in[6]; p.fox_k_norm_g = (const float*)d_in[7];
    p.w_proj_conv = (const float*)d_in[8]; p.w_proj_fox = (const float*)d_in[9]; p.w_proj_sb = (const float*)d_in[10]; p.w_out = (const float*)d_in[11];
    p.norm2_g = (const float*)d_in[12]; p.w_up = (const float*)d_in[13]; p.ffn_conv_w = (const float*)d_in[14]; p.ffn_conv_b = (const float*)d_in[15];
    p.w_down = (const float*)d_in[16]; p.out = (float*)d_out; p.ws = (unsigned char*)d_ws;
    (void)hipMemsetAsync((char*)d_ws + WS_BAR, 0, CTL_MEMSET_BYTES, stream);
    void* args[] = {&p};
    hipError_t e = hipLaunchCooperativeKernel((const void*)fwd_megakernel, dim3(grid), dim3(NTHR), args, LDS_BYTES, stream);
    if (e != hipSuccess) fprintf(stderr, "cooperative launch failed: %s (grid %d)\n", hipGetErrorString(e), grid);
}
```

```cpp
#include <hip/hip_runtime.h>
#include <hip/hip_cooperative_groups.h>
#include <cstdio>
#include <cstdint>
namespace cg = cooperative_groups;

constexpr int DM = 1024, BATCH = 8, SEQ = 2048, DEPTH = 4, MTOK = BATCH * SEQ;
constexpr int DIN = 7688, NIN = 7936, DFF = 2816, NUP = 2 * DFF;
constexpr int PA_P = 4608, G_P = 3072, MIX_P = 1536;
constexpr float NORM_EPS = 1e-6f;
constexpr float LOG2E = 1.4426950408889634f;
constexpr float SSQ_SCALE = 1048576.0f, SSQ_INV = 1.0f / 1048576.0f;

namespace pg8 {
#define PG8_LAS __attribute__((address_space(3)))
typedef unsigned short bf16_t;
typedef short bf16x8 __attribute__((ext_vector_type(8)));
typedef float f32x4 __attribute__((ext_vector_type(4)));
typedef unsigned u32x4 __attribute__((ext_vector_type(4)));
typedef unsigned u32x2 __attribute__((ext_vector_type(2)));
constexpr int BM = 256, BK = 64, HALF = 128, HTB = HALF * BK * 2  , STAGE_BYTES = 8 * HTB, NXCD = 8, WGM = 8;

__host__ __device__ __forceinline__ int lds_byte(int r, int c) { const int st = (r >> 4) * 2 + (c >> 5), rr = r & 15, cc = c & 31, ob = rr * 64 + cc * 2; return st * 1024 + (ob ^ (((ob >> 9) & 1) << 5)); }
__host__ __device__ __forceinline__ void stage_rc(int b, int& R, int& C) { const int st = b / 1024, sb = b % 1024, swz = sb ^ (((sb >> 9) & 1) << 5); R = (st >> 1) * 16 + swz / 64; C = (st & 1) * 32 + (swz % 64) / 2; }
__host__ __device__ __forceinline__ int perm32(int rho) { const int n = rho >> 4, i = rho & 15; return 8 * (i >> 2) + 4 * n + (i & 3); }

struct Unit { int pm, pn; };
struct Gemm { const bf16_t* A; const bf16_t* Bt; int M, N, K, lda, ldb, a_div, a_colstep, nbt; };

struct StaticOrder {
    int nM, nN, nwg, G, c;
    __host__ __device__ void init(int M, int N, int G_, int c_) { nM = M / BM; nN = N / BM; nwg = nM * nN; G = G_; c = c_; }
    __host__ __device__ bool next(int i, Unit& u) const {
        const long L = (long)i * G + c; if (L >= nwg) return false;
        int wgid = (int)L; { const int q = nwg / NXCD, r = nwg % NXCD, xcd = wgid % NXCD, off = wgid / NXCD; wgid = (xcd < r ? xcd * (q + 1) : r * (q + 1) + (xcd - r) * q) + off; }
        const int nig = WGM * nN, gid = wgid / nig, fm = gid * WGM, gsz = (nM - fm) < WGM ? (nM - fm) : WGM;
        u.pm = fm + ((wgid % nig) % gsz); u.pn = (wgid % nig) / gsz; return true;
    }
    __device__ __forceinline__ void a_ready(const Unit&) const {}
    __device__ __forceinline__ void done(const Unit&) const {}
};


__device__ __forceinline__ unsigned cvt_pk_bf16(float lo, float hi) { unsigned r; asm volatile("v_cvt_pk_bf16_f32 %0, %1, %2" : "=v"(r) : "v"(lo), "v"(hi)); return r; }
__device__ __forceinline__ float bflo(unsigned u) { return __uint_as_float(u << 16); }
__device__ __forceinline__ float bfhi(unsigned u) { return __uint_as_float(u & 0xffff0000u); }
__device__ __forceinline__ float sigmoidf_(float x) { return __builtin_amdgcn_rcpf(1.0f + __expf(-x)); }

struct EpiIn {
    static constexpr bool PERM = true, AFTER_DRAIN = false; static constexpr int HOOK_EVERY = 0;
    bf16_t* PA; bf16_t* G; float* LF; const unsigned long long* ssq; const float* gbias; const float* fbias;
    __device__ __forceinline__ void operator()(const f32x4 (&acc)[2][2][4][2], const Unit& u, int wr, int wc, int fr, int fq) const {
        const int row0 = u.pm * BM + wr * 64 + fr;
        const int col0 = u.pn * BM + wc * 32 + 8 * fq;
        unsigned long long sq[2][4];
#pragma unroll
        for (int ai = 0; ai < 2; ++ai)
#pragma unroll
            for (int m = 0; m < 4; ++m) sq[ai][m] = ssq[row0 + ai * HALF + m * 16];
        const bool gate = (u.pn >= 18) && (u.pn < 30);
        float rs[2][4];
#pragma unroll
        for (int ai = 0; ai < 2; ++ai)
#pragma unroll
            for (int m = 0; m < 4; ++m) rs[ai][m] = rsqrtf((float)sq[ai][m] * (SSQ_INV / DM) + NORM_EPS);
        if (u.pn < 30) {
            bf16_t* base = gate ? G + (col0 - PA_P) : PA + col0; const int ldc = gate ? G_P : PA_P;
#pragma unroll
            for (int bj = 0; bj < 2; ++bj) {
                f32x4 b0 = (f32x4){0.f, 0.f, 0.f, 0.f}, b1 = b0;
                if (gate) { b0 = *(const f32x4*)(gbias + (col0 - PA_P) + bj * HALF); b1 = *(const f32x4*)(gbias + (col0 - PA_P) + bj * HALF + 4); }
#pragma unroll
                for (int ai = 0; ai < 2; ++ai)
#pragma unroll
                    for (int m = 0; m < 4; ++m) { const int row = row0 + ai * HALF + m * 16;
                        f32x4 v0 = acc[ai][bj][m][0] * rs[ai][m] + b0, v1 = acc[ai][bj][m][1] * rs[ai][m] + b1;
                        if (gate) {
#pragma unroll
                            for (int e = 0; e < 4; ++e) { v0[e] = sigmoidf_(v0[e]); v1[e] = sigmoidf_(v1[e]); } }
                        u32x4 w; w.x = cvt_pk_bf16(v0[0], v0[1]); w.y = cvt_pk_bf16(v0[2], v0[3]); w.z = cvt_pk_bf16(v1[0], v1[1]); w.w = cvt_pk_bf16(v1[2], v1[3]);
                        *(u32x4*)(base + (size_t)row * ldc + bj * HALF) = w; }
            }
        } else {
            if (wc == 0 && fq == 0) {
#pragma unroll
                for (int ai = 0; ai < 2; ++ai)
#pragma unroll
                    for (int m = 0; m < 4; ++m) { const int row = row0 + ai * HALF + m * 16;
                        f32x4 v0 = acc[ai][0][m][0] * rs[ai][m] + *(const f32x4*)(fbias), v1 = acc[ai][0][m][1] * rs[ai][m] + *(const f32x4*)(fbias + 4);
#pragma unroll
                        for (int e = 0; e < 4; ++e) { v0[e] = fminf(v0[e], 0.f) - __logf(1.0f + __expf(-fabsf(v0[e]))); v1[e] = fminf(v1[e], 0.f) - __logf(1.0f + __expf(-fabsf(v1[e]))); }
                        *(f32x4*)(LF + (size_t)row * 8) = v0; *(f32x4*)(LF + (size_t)row * 8 + 4) = v1; }
            }
        }
    }
};
__device__ __forceinline__ float dpp_ror1(float v) { return __int_as_float(__builtin_amdgcn_update_dpp(0, __float_as_int(v), 0x121, 0xf, 0xf, false)); }
__device__ __forceinline__ float dpp_ror2(float v) { return __int_as_float(__builtin_amdgcn_update_dpp(0, __float_as_int(v), 0x122, 0xf, 0xf, false)); }
struct EpiGlu {
    static constexpr bool PERM = true, AFTER_DRAIN = false; static constexpr int HOOK_EVERY = 0;
    bf16_t* H; float* SG; float* SV; const unsigned long long* ssq; const float* cw; const float* cb;
    __device__ __forceinline__ void operator()(const f32x4 (&acc)[2][2][4][2], const Unit& u, int wr, int wc, int fr, int fq) const {
        const int row0 = u.pm * BM + wr * 64 + fr;
        unsigned long long sq[2][4];
#pragma unroll
        for (int ai = 0; ai < 2; ++ai)
#pragma unroll
            for (int m = 0; m < 4; ++m) sq[ai][m] = ssq[row0 + ai * HALF + m * 16];
        float rsv[2][4];
#pragma unroll
        for (int ai = 0; ai < 2; ++ai)
#pragma unroll
            for (int m = 0; m < 4; ++m) rsv[ai][m] = rsqrtf((float)sq[ai][m] * (SSQ_INV / DM) + NORM_EPS);
#pragma unroll
        for (int n = 0; n < 2; ++n) {
            const int c0 = u.pn * HALF + wc * 32 + 8 * fq + 4 * n;
            const f32x4 w0 = *(const f32x4*)(cw + c0), w1 = *(const f32x4*)(cw + DFF + c0), w2 = *(const f32x4*)(cw + 2 * DFF + c0), bb = *(const f32x4*)(cb + c0);
#pragma unroll
            for (int ai = 0; ai < 2; ++ai) {
                const int blk = u.pm * 4 + ai * 2 + wr;
                f32x4 p1 = (f32x4){0.f, 0.f, 0.f, 0.f}, p2 = p1;
#pragma unroll
                for (int m = 0; m < 4; ++m) { const int row = row0 + ai * HALF + m * 16; const float rs = rsv[ai][m];
                    const f32x4 g = acc[ai][0][m][n] * rs, v = acc[ai][1][m][n] * rs;
                    f32x4 r1, r2;
#pragma unroll
                    for (int e = 0; e < 4; ++e) { r1[e] = dpp_ror1(g[e]); r2[e] = dpp_ror2(g[e]); }
                    const f32x4 q1 = (fr >= 1) ? r1 : p1, q2 = (fr >= 2) ? r2 : p2;
                    p1 = r1; p2 = r2;
                    f32x4 pre = w0 * q2 + w1 * q1 + w2 * g + bb, hv;
#pragma unroll
                    for (int e = 0; e < 4; ++e) hv[e] = pre[e] * __builtin_amdgcn_rcpf(1.0f + __builtin_amdgcn_exp2f(-LOG2E * pre[e])) * v[e];
                    if (m == 0) { if (fr < 2) { *(f32x4*)(SG + ((size_t)blk * 4 + 2 + fr) * DFF + c0) = g; *(f32x4*)(SV + ((size_t)blk * 2 + fr) * DFF + c0) = v; } }
                    if (m == 3) { if (fr >= 14) *(f32x4*)(SG + ((size_t)blk * 4 + (fr - 14)) * DFF + c0) = g; }
                    if (m > 0 || fr >= 2) { u32x2 w; w.x = cvt_pk_bf16(hv[0], hv[1]); w.y = cvt_pk_bf16(hv[2], hv[3]); *(u32x2*)(H + (size_t)row * DFF + c0) = w; }
                    asm volatile("" ::: "memory"); }
            }
        }
    }
};
struct EpiMerge {
    static constexpr bool PERM = true, AFTER_DRAIN = false; static constexpr int HOOK_EVERY = 8;
    bf16_t* O; const bf16_t* G;
    __device__ __forceinline__ void mid(f32x4 (&acc)[2][2][4][2], const Unit& u, int seg, int wr, int wc, int fr, int fq) const {
        int row0 = u.pm * BM + wr * 64 + fr; const int col0 = u.pn * BM + wc * 32 + 8 * fq;
        asm volatile("" : "+v"(row0));
#pragma unroll
        for (int aim = 0; aim < 4; ++aim) { const int ai = aim >> 1, mb = (aim & 1) * 2;
            u32x4 ga[2][2], gb[2][2];
#pragma unroll
            for (int mm = 0; mm < 2; ++mm) { const bf16_t* gp = G + (size_t)(row0 + ai * HALF + (mb + mm) * 16) * G_P + col0 + (seg - 1) * 1024;
#pragma unroll
                for (int bj = 0; bj < 2; ++bj) { ga[mm][bj] = *(const u32x4*)(gp + bj * HALF); gb[mm][bj] = *(const u32x4*)(gp + bj * HALF + 1024); } }
#pragma unroll
            for (int mm = 0; mm < 2; ++mm)
#pragma unroll
                for (int bj = 0; bj < 2; ++bj) { const u32x4 a = ga[mm][bj], b = gb[mm][bj]; const int m = mb + mm;
                    f32x4& a0 = acc[ai][bj][m][0]; f32x4& a1 = acc[ai][bj][m][1];
                    a0[0] *= fmaxf(bflo(a.x), 1e-6f) * __builtin_amdgcn_rcpf(fmaxf(bflo(b.x), 1e-6f)); a0[1] *= fmaxf(bfhi(a.x), 1e-6f) * __builtin_amdgcn_rcpf(fmaxf(bfhi(b.x), 1e-6f));
                    a0[2] *= fmaxf(bflo(a.y), 1e-6f) * __builtin_amdgcn_rcpf(fmaxf(bflo(b.y), 1e-6f)); a0[3] *= fmaxf(bfhi(a.y), 1e-6f) * __builtin_amdgcn_rcpf(fmaxf(bfhi(b.y), 1e-6f));
                    a1[0] *= fmaxf(bflo(a.z), 1e-6f) * __builtin_amdgcn_rcpf(fmaxf(bflo(b.z), 1e-6f)); a1[1] *= fmaxf(bfhi(a.z), 1e-6f) * __builtin_amdgcn_rcpf(fmaxf(bfhi(b.z), 1e-6f));
                    a1[2] *= fmaxf(bflo(a.w), 1e-6f) * __builtin_amdgcn_rcpf(fmaxf(bflo(b.w), 1e-6f)); a1[3] *= fmaxf(bfhi(a.w), 1e-6f) * __builtin_amdgcn_rcpf(fmaxf(bfhi(b.w), 1e-6f)); }
            asm volatile("" ::: "memory"); }
    }
    __device__ __forceinline__ void operator()(const f32x4 (&acc)[2][2][4][2], const Unit& u, int wr, int wc, int fr, int fq) const {
        const int row0 = u.pm * BM + wr * 64 + fr, col0 = u.pn * BM + wc * 32 + 8 * fq;
#pragma unroll
        for (int aim = 0; aim < 4; ++aim) { const int ai = aim >> 1, mb = (aim & 1) * 2;
            u32x4 gv[2][2];
#pragma unroll
            for (int mm = 0; mm < 2; ++mm)
#pragma unroll
                for (int bj = 0; bj < 2; ++bj) gv[mm][bj] = *(const u32x4*)(G + (size_t)(row0 + ai * HALF + (mb + mm) * 16) * G_P + 2048 + col0 + bj * HALF);
#pragma unroll
            for (int mm = 0; mm < 2; ++mm) { const int m = mb + mm; const int row = row0 + ai * HALF + m * 16;
#pragma unroll
                for (int bj = 0; bj < 2; ++bj) { const u32x4 g = gv[mm][bj];
                    const f32x4 a0 = acc[ai][bj][m][0], a1 = acc[ai][bj][m][1];
                    u32x4 w; w.x = cvt_pk_bf16(a0[0] * fmaxf(bflo(g.x), 1e-6f), a0[1] * fmaxf(bfhi(g.x), 1e-6f)); w.y = cvt_pk_bf16(a0[2] * fmaxf(bflo(g.y), 1e-6f), a0[3] * fmaxf(bfhi(g.y), 1e-6f));
                    w.z = cvt_pk_bf16(a1[0] * fmaxf(bflo(g.z), 1e-6f), a1[1] * fmaxf(bfhi(g.z), 1e-6f)); w.w = cvt_pk_bf16(a1[2] * fmaxf(bflo(g.w), 1e-6f), a1[3] * fmaxf(bfhi(g.w), 1e-6f));
                    *(u32x4*)(O + (size_t)row * DM + col0 + bj * HALF) = w; } }
            asm volatile("" ::: "memory"); }
    }
};
struct EpiRes {
    static constexpr bool PERM = false, AFTER_DRAIN = false; static constexpr int HOOK_EVERY = 0;
    const float* Xin; float* X; bf16_t* XB; unsigned long long* ssq_out;
    __device__ __forceinline__ void operator()(const f32x4 (&acc)[2][2][4][2], const Unit& u, int wr, int wc, int fr, int fq) const {
        const int row0 = u.pm * BM + wr * 64 + fr, col0 = u.pn * BM + wc * 32 + 4 * fq;
#pragma unroll
        for (int ai = 0; ai < 2; ++ai)
#pragma unroll
            for (int m = 0; m < 4; ++m) { const int row = row0 + ai * HALF + m * 16; const size_t off = (size_t)row * DM + col0; float s = 0.f;
#pragma unroll
                for (int bj = 0; bj < 2; ++bj)
#pragma unroll
                    for (int n = 0; n < 2; ++n) { const size_t o2 = off + bj * HALF + n * 16; const f32x4 xn = *(const f32x4*)(Xin + o2) + acc[ai][bj][m][n];
                        *(f32x4*)(X + o2) = xn;
                        if (XB) { u32x2 w; w.x = cvt_pk_bf16(xn[0], xn[1]); w.y = cvt_pk_bf16(xn[2], xn[3]); *(u32x2*)(XB + o2) = w; }
                        s += (xn[0] * xn[0] + xn[1] * xn[1]) + (xn[2] * xn[2] + xn[3] * xn[3]); }
                if (ssq_out) { s += __shfl_xor(s, 16); s += __shfl_xor(s, 32); if (fq == 0) atomicAdd(ssq_out + row, (unsigned long long)__float2ll_rn(s * SSQ_SCALE)); } }
    }
};

template <class Epi, class Sched, bool ALIGN_EPI = false, bool SP2 = false>
__device__ __forceinline__ void gemm_phase(PG8_LAS unsigned char* lds, const Gemm g, const Sched& S, const Epi& E) {
    int tid_ = threadIdx.x; asm volatile("" : "+v"(tid_));
    const int tid = tid_, wid = __builtin_amdgcn_readfirstlane(tid >> 6), lane = tid & 63, wr = wid >> 2, wc = wid & 3, fr = lane & 15, fq = lane >> 4;
    const int K = g.K, nt = K / BK;
    unsigned voffA[2], voffB[2];
#pragma unroll
    for (int i = 0; i < 2; ++i) { int R, C; stage_rc(tid * 16 + i * 8192, R, C); const int Rb = Epi::PERM ? ((R & ~31) + perm32(R & 31)) : R;
        voffA[i] = (unsigned)(R * g.lda + C) * 2u; voffB[i] = (unsigned)(Rb * g.ldb + C) * 2u; }
    const size_t kstep = (size_t)(BK * 2);
    const size_t hstepA = (size_t)HALF * g.lda * 2, hstepB = (size_t)HALF * g.ldb * 2;
    const size_t tstepA = 2 * hstepA, tstepB = 2 * hstepB;
    const unsigned ldsw = (unsigned)wid * 1024u;
    const int aoff = lds_byte(wr * 64 + fr, fq * 8), boff = lds_byte(wc * 32 + fr, fq * 8);
#define PG8_SA(b, h) (((b) * 2 + (h)) * HTB)
#define PG8_SB(b, h) ((4 + (b) * 2 + (h)) * HTB)
#define PG8_STAGE(bufoff, gbase, voff) do { _Pragma("unroll") for (int _i = 0; _i < 2; ++_i) \
        __builtin_amdgcn_global_load_lds((const unsigned*)((const char*)(gbase) + (voff)[_i]), (PG8_LAS unsigned*)(lds + (bufoff) + ldsw + _i * 8192), 16, 0, 0); } while (0)
#define PG8_LDA(dst, b, h) do { _Pragma("unroll") for (int m = 0; m < 4; ++m) _Pragma("unroll") for (int k = 0; k < 2; ++k) dst[m][k] = *(const PG8_LAS bf16x8*)(lds + PG8_SA(b, h) + aoff + m * 2048 + k * 1024); } while (0)
#define PG8_LDB(dst, b, h) do { _Pragma("unroll") for (int n = 0; n < 2; ++n) _Pragma("unroll") for (int k = 0; k < 2; ++k) dst[n][k] = *(const PG8_LAS bf16x8*)(lds + PG8_SB(b, h) + boff + n * 2048 + k * 1024); } while (0)
#define PG8_MMA(ai, bj, At, Bt) do { __builtin_amdgcn_s_setprio(1); _Pragma("unroll") for (int m = 0; m < 4; ++m) _Pragma("unroll") for (int n = 0; n < 2; ++n) _Pragma("unroll") for (int k = 0; k < 2; ++k) \
        acc[ai][bj][m][n] = __builtin_amdgcn_mfma_f32_16x16x32_bf16(Bt[n][k], At[m][k], acc[ai][bj][m][n], 0, 0, 0); __builtin_amdgcn_s_setprio(0); } while (0)
#define PG8_WAIT_V(n) asm volatile("s_waitcnt vmcnt(" #n ")" ::: "memory")
#define PG8_WAIT_L(n) asm volatile("s_waitcnt lgkmcnt(" #n ")" ::: "memory")
#define PG8_BAR __builtin_amdgcn_s_barrier()
#define PG8_SCHED __builtin_amdgcn_sched_barrier(0)
    Unit cur, nxt; int ui = 0;
    if (!S.next(0, cur)) return;
    f32x4 acc[2][2][4][2];
#pragma unroll
    for (int a = 0; a < 2; ++a)
#pragma unroll
        for (int b = 0; b < 2; ++b)
#pragma unroll
            for (int m = 0; m < 4; ++m)
#pragma unroll
                for (int n = 0; n < 2; ++n) acc[a][b][m][n] = (f32x4){0.f, 0.f, 0.f, 0.f};
    bf16x8 At[4][2], B0[2][2], B1[2][2];
    const char* cA = (const char*)g.A + (size_t)cur.pm * tstepA + (size_t)(cur.pn / g.a_div) * g.a_colstep; const char* cB = (const char*)g.Bt + (size_t)cur.pn * tstepB;
    S.a_ready(cur);
    if constexpr (SP2) {
        PG8_STAGE(PG8_SB(0, 0), cB, voffB); PG8_STAGE(PG8_SB(0, 1), cB + hstepB, voffB); PG8_STAGE(PG8_SA(0, 0), cA, voffA); PG8_STAGE(PG8_SA(0, 1), cA + hstepA, voffA);
        if (wr == 1) PG8_BAR;
        PG8_WAIT_V(2); PG8_BAR;
        PG8_STAGE(PG8_SB(1, 0), cB + kstep, voffB); PG8_STAGE(PG8_SA(1, 0), cA + kstep, voffA); PG8_STAGE(PG8_SB(1, 1), cB + hstepB + kstep, voffB);
        PG8_WAIT_V(6); PG8_BAR;
    } else {
        PG8_STAGE(PG8_SB(0, 0), cB, voffB); PG8_STAGE(PG8_SA(0, 0), cA, voffA); PG8_STAGE(PG8_SB(0, 1), cB + hstepB, voffB); PG8_STAGE(PG8_SA(0, 1), cA + hstepA, voffA);
        if (wr == 1) PG8_BAR;
        PG8_WAIT_V(4); PG8_BAR;
        PG8_STAGE(PG8_SB(1, 0), cB + kstep, voffB); PG8_STAGE(PG8_SA(1, 0), cA + kstep, voffA); PG8_STAGE(PG8_SB(1, 1), cB + hstepB + kstep, voffB);
        PG8_WAIT_V(6); PG8_BAR;
    }
    for (;;) {
        const bool has_next = S.next(ui + 1, nxt);
        const char* nA = has_next ? (const char*)g.A + (size_t)nxt.pm * tstepA + (size_t)(nxt.pn / g.a_div) * g.a_colstep : cA; const char* nB = has_next ? (const char*)g.Bt + (size_t)nxt.pn * tstepB : cB;
        int tb = 0;
        for (int t = 0; t < nt; t += 2) {
            const bool last = (t == nt - 2);
            if constexpr (Epi::HOOK_EVERY > 0) { if (t > 0 && (t % Epi::HOOK_EVERY) == 0) E.mid(acc, cur, t / Epi::HOOK_EVERY, wr, wc, fr, fq); }
            const char* a1 = cA + (size_t)(t + 1) * kstep;
            const char* a2 = last ? nA : cA + (size_t)(t + 2) * kstep; tb += 2; if (tb >= g.nbt) tb -= g.nbt; const char* b2 = last ? nB : cB + (size_t)tb * kstep;
            const char* a3 = a2 + kstep; const char* b3 = b2 + kstep;
            if (last && has_next) S.a_ready(nxt);
            if constexpr (SP2) {
            PG8_LDB(B0, 0, 0); PG8_LDB(B1, 0, 1); PG8_SCHED; PG8_LDA(At, 0, 0); PG8_STAGE(PG8_SA(1, 1), a1 + hstepA, voffA);
            PG8_WAIT_V(8); PG8_WAIT_L(0); PG8_BAR; PG8_MMA(0, 0, At, B0); PG8_MMA(0, 1, At, B1); PG8_BAR; PG8_SCHED;
            PG8_LDA(At, 0, 1); PG8_STAGE(PG8_SB(0, 0), b2, voffB); PG8_STAGE(PG8_SB(0, 1), b2 + hstepB, voffB); PG8_STAGE(PG8_SA(0, 0), a2, voffA);
            PG8_WAIT_V(8); PG8_WAIT_L(0); PG8_BAR; PG8_MMA(1, 0, At, B0); PG8_MMA(1, 1, At, B1); PG8_BAR; PG8_SCHED;
            PG8_LDB(B0, 1, 0); PG8_LDB(B1, 1, 1); PG8_SCHED; PG8_LDA(At, 1, 0); PG8_STAGE(PG8_SA(0, 1), a2 + hstepA, voffA);
            PG8_WAIT_V(8); PG8_WAIT_L(0); PG8_BAR; PG8_MMA(0, 0, At, B0); PG8_MMA(0, 1, At, B1); PG8_BAR; PG8_SCHED;
            PG8_LDA(At, 1, 1); PG8_STAGE(PG8_SB(1, 0), b3, voffB); PG8_STAGE(PG8_SB(1, 1), b3 + hstepB, voffB); PG8_STAGE(PG8_SA(1, 0), a3, voffA);
            PG8_WAIT_V(8); PG8_WAIT_L(0); PG8_BAR; PG8_MMA(1, 0, At, B0); PG8_MMA(1, 1, At, B1); PG8_BAR; PG8_SCHED;
            } else {
            PG8_LDB(B0, 0, 0); PG8_SCHED; PG8_LDA(At, 0, 0); PG8_STAGE(PG8_SA(1, 1), a1 + hstepA, voffA);
            PG8_WAIT_L(8); PG8_BAR; PG8_WAIT_L(0); PG8_MMA(0, 0, At, B0); PG8_BAR; PG8_SCHED;
            PG8_LDB(B1, 0, 1); PG8_STAGE(PG8_SB(0, 0), b2, voffB);
            PG8_BAR; PG8_WAIT_L(0); PG8_MMA(0, 1, At, B1); PG8_BAR;
            PG8_LDA(At, 0, 1); PG8_STAGE(PG8_SA(0, 0), a2, voffA);
            PG8_BAR; PG8_WAIT_L(0); PG8_MMA(1, 0, At, B0); PG8_BAR; PG8_SCHED;
            PG8_STAGE(PG8_SB(0, 1), b2 + hstepB, voffB);
            PG8_WAIT_V(6); PG8_BAR; PG8_MMA(1, 1, At, B1); PG8_BAR;
            PG8_LDB(B0, 1, 0); PG8_SCHED; PG8_LDA(At, 1, 0); PG8_STAGE(PG8_SA(0, 1), a2 + hstepA, voffA);
            PG8_WAIT_L(8); PG8_BAR; PG8_WAIT_L(0); PG8_MMA(0, 0, At, B0); PG8_BAR; PG8_SCHED;
            PG8_LDB(B1, 1, 1); PG8_STAGE(PG8_SB(1, 0), b3, voffB);
            PG8_BAR; PG8_WAIT_L(0); PG8_MMA(0, 1, At, B1); PG8_BAR;
            PG8_LDA(At, 1, 1); PG8_STAGE(PG8_SA(1, 0), a3, voffA);
            PG8_BAR; PG8_WAIT_L(0); PG8_MMA(1, 0, At, B0); PG8_BAR; PG8_SCHED;
            PG8_STAGE(PG8_SB(1, 1), b3 + hstepB, voffB);
            PG8_WAIT_V(6); PG8_BAR; PG8_MMA(1, 1, At, B1); PG8_BAR;
            }
        }
        if constexpr (ALIGN_EPI) { if (wr == 0) PG8_BAR; }
        if constexpr (!Epi::AFTER_DRAIN) { E(acc, cur, wr, wc, fr, fq); S.done(cur); }
        if (!has_next) break;
#pragma unroll
        for (int a = 0; a < 2; ++a)
#pragma unroll
            for (int b = 0; b < 2; ++b)
#pragma unroll
                for (int m = 0; m < 4; ++m)
#pragma unroll
                    for (int n = 0; n < 2; ++n) acc[a][b][m][n] = (f32x4){0.f, 0.f, 0.f, 0.f};
        cur = nxt; cA = nA; cB = nB; ++ui;
        if constexpr (ALIGN_EPI) { if (wr == 1) PG8_BAR; }
    }
    PG8_WAIT_V(0);
    if constexpr (!ALIGN_EPI) { if (wr == 0) PG8_BAR; }
    PG8_BAR;
    if constexpr (Epi::AFTER_DRAIN) { E.fused(acc, cur, wr, wc, fr, fq, lds, wid, lane); S.done(cur); }
#undef PG8_SA
#undef PG8_SB
#undef PG8_STAGE
#undef PG8_LDA
#undef PG8_LDB
#undef PG8_MMA
#undef PG8_WAIT_V
#undef PG8_WAIT_L
#undef PG8_BAR
#undef PG8_SCHED
}
}

#define LAS __attribute__((address_space(3)))
typedef unsigned short bf16;
typedef unsigned v4u __attribute__((ext_vector_type(4)));
typedef unsigned v2u __attribute__((ext_vector_type(2)));
typedef float f32x4 __attribute__((ext_vector_type(4)));
constexpr int NTHR = 512, NWAVES = 8;
constexpr int LDS_XB_OFF = 131072;
constexpr int LDS_BYTES = 147456;
constexpr size_t MiB = 1u << 20;
constexpr size_t WS_SSQ = 0;
constexpr size_t WS_LF = 1 * MiB;
constexpr size_t WS_BAR = 1 * MiB + 512 * 1024;
constexpr size_t WS_C_UNUSED = 1 * MiB + 768 * 1024;
constexpr size_t WS_XB = 2 * MiB;
constexpr size_t WS_W = 34 * MiB;
constexpr size_t W_IN = 0, W_P = (size_t)NIN * DM * 2, W_OUT = W_P + (size_t)3072 * 512 * 2, W_UP = W_OUT + (size_t)DM * DM * 2, W_DOWN = W_UP + (size_t)NUP * DM * 2, W_LAYER = W_DOWN + (size_t)DM * DFF * 2;
static_assert(W_LAYER == 37 * MiB, "weights per layer");
constexpr size_t WS_PA = WS_W + 4 * W_LAYER;
constexpr size_t WS_YG = WS_PA;
constexpr size_t WS_G = WS_PA + 144 * MiB;
constexpr size_t WS_MIX = WS_G + 96 * MiB;
constexpr size_t WS_U = WS_PA;
constexpr size_t WS_SG = WS_U, WS_SV = WS_U + 16 * MiB;
constexpr size_t WS_H = WS_U + 176 * MiB;
constexpr size_t WS_END = WS_MIX + 48 * MiB;
static_assert(WS_H + 88 * MiB <= WS_END, "ws map");

struct Params {
    const float* x; const float* norm1_g; const float* w_in; const float* fox_f_bias; const float* gate_bias; const float* conv_w;
    const float* fox_q_norm_g; const float* fox_k_norm_g; const float* w_proj_conv; const float* w_proj_fox; const float* w_proj_sb;
    const float* w_out; const float* norm2_g; const float* w_up; const float* ffn_conv_w; const float* ffn_conv_b; const float* w_down;
    float* out; unsigned char* ws;
};

__device__ __forceinline__ unsigned f2bf(float f) { unsigned u = __builtin_bit_cast(unsigned, f); return (u + 0x7fffu + ((u >> 16) & 1u)) >> 16; }
__device__ __forceinline__ unsigned pk2(float lo, float hi) { return f2bf(lo) | (f2bf(hi) << 16); }
__device__ __forceinline__ float blo(unsigned u) { return __uint_as_float(u << 16); }
__device__ __forceinline__ float bhi(unsigned u) { return __uint_as_float(u & 0xffff0000u); }
__device__ __forceinline__ float wave_sum(float v) {
#pragma unroll
    for (int o = 1; o < 64; o <<= 1) v += __shfl_xor(v, o);
    return v;
}
__device__ __forceinline__ void unpack8(const v4u w, float (&f)[8]) { f[0] = blo(w.x); f[1] = bhi(w.x); f[2] = blo(w.y); f[3] = bhi(w.y); f[4] = blo(w.z); f[5] = bhi(w.z); f[6] = blo(w.w); f[7] = bhi(w.w); }

__device__ __forceinline__ void tr_item(const float* W, int ldw, int scol, int nvalid, int ldk, const float* g, bf16* WT, int drow, int nblk, int item, LAS float* scr, int lane, int kofs = 0) {
    const int kb = item / nblk, nb = item % nblk, k0 = 64 * kb, n0 = 32 * nb;
    const int nn = n0 + (lane & 31); const bool ok = nn < nvalid;
    float tv[32];
    const float* src = W + (size_t)(k0 + (lane >> 5)) * ldw + scol + nn;
#pragma unroll
    for (int i = 0; i < 32; ++i) tv[i] = ok ? src[(size_t)(2 * i) * ldw] : 0.f;
    if (g) {
#pragma unroll
        for (int i = 0; i < 32; ++i) tv[i] *= g[k0 + 2 * i + (lane >> 5)];
    }
#pragma unroll
    for (int i = 0; i < 32; ++i) scr[(2 * i + (lane >> 5)) * 33 + (lane & 31)] = tv[i];
    asm volatile("s_waitcnt lgkmcnt(0)" ::: "memory");
    const int c = lane & 7;
#pragma unroll
    for (int j = 0; j < 4; ++j) { const int n = (lane >> 3) + 8 * j; const LAS float* s = scr + (8 * c) * 33 + n;
        v4u o; o.x = pk2(s[0 * 33], s[1 * 33]); o.y = pk2(s[2 * 33], s[3 * 33]); o.z = pk2(s[4 * 33], s[5 * 33]); o.w = pk2(s[6 * 33], s[7 * 33]);
        *(v4u*)(WT + (size_t)(drow + n0 + n) * ldk + kofs + k0 + 8 * c) = o; }
    asm volatile("s_waitcnt lgkmcnt(0)" ::: "memory");
}

__device__ __forceinline__ void prologue(const Params& p, LAS unsigned char* lds, int vcu, int G, int wave, int lane, int tid) {
    LAS float* scr = (LAS float*)(lds + wave * 16384);
    const int gw = vcu * NWAVES + wave, NGW = G * NWAVES;
    constexpr int I0 = 1536, I1 = I0 + 2304, I2 = I1 + 128, I3 = I2 + 768, I4 = I3 + 512, I5 = I4 + 2816, I6 = I5 + 1408;
    for (int it = gw; it < DEPTH * I6; it += NGW) {
        const int l = it / I6; int r = it % I6;
        unsigned char* wl = p.ws + WS_W + (size_t)l * W_LAYER;
        const float* win = p.w_in + (size_t)l * DM * DIN; const float* g1 = p.norm1_g + l * DM;
        if (r < I0) { tr_item(win, DIN, 0, 3072, DM, g1, (bf16*)(wl + W_IN), 0, 96, r, scr, lane); continue; }
        if (r < I1) { tr_item(win, DIN, 3080, 4608, DM, g1, (bf16*)(wl + W_IN), 3072, 144, r - I0, scr, lane); continue; }
        if (r < I2) { tr_item(win, DIN, 3072, 8, DM, g1, (bf16*)(wl + W_IN), 7680, 8, r - I1, scr, lane); continue; }
        if (r < I3) { r -= I2; const int b = r / 256; const float* wp = (b == 0 ? p.w_proj_conv : b == 1 ? p.w_proj_fox : p.w_proj_sb) + (size_t)l * 512 * DM;
                      tr_item(wp, DM, 0, DM, 1536, nullptr, (bf16*)(wl + W_P), 0, 32, r % 256, scr, lane, 512 * b); continue; }
        if (r < I4) { tr_item(p.w_out + (size_t)l * DM * DM, DM, 0, DM, DM, nullptr, (bf16*)(wl + W_OUT), 0, 32, r - I3, scr, lane); continue; }
        if (r < I5) { r -= I4; const int nb = r % 176, j = nb >> 3, q = nb & 7, src = (q < 4) ? 128 * j + 32 * q : DFF + 128 * j + 32 * (q - 4);
                      tr_item(p.w_up + (size_t)l * DM * NUP, NUP, src - 32 * nb, 1 << 30, DM, p.norm2_g + l * DM, (bf16*)(wl + W_UP), 0, 176, r, scr, lane); continue; }
        tr_item(p.w_down + (size_t)l * DFF * DM, DM, 0, DM, DFF, nullptr, (bf16*)(wl + W_DOWN), 0, 32, r - I5, scr, lane);
    }
    unsigned long long* ssq = (unsigned long long*)(p.ws + WS_SSQ); bf16* XB = (bf16*)(p.ws + WS_XB);
    for (int m = gw; m < MTOK; m += NGW) {
        const f32x4* xr = (const f32x4*)(p.x + (size_t)m * DM) + lane; v2u* xb = (v2u*)(XB + (size_t)m * DM) + lane;
        float s = 0.f;
#pragma unroll
        for (int j = 0; j < 4; ++j) { const f32x4 v = xr[64 * j]; v2u w; w.x = pk2(v.x, v.y); w.y = pk2(v.z, v.w); xb[64 * j] = w; s += (v.x * v.x + v.y * v.y) + (v.z * v.z + v.w * v.w); }
        s = wave_sum(s);
        if (lane == 0) ssq[m] = (unsigned long long)__float2ll_rn(s * SSQ_SCALE);
    }
    for (int i = vcu * NTHR + tid; i < 7 * MTOK; i += G * NTHR) ssq[MTOK + i] = 0ull;
}

__device__ __forceinline__ void conv_mixer(const bf16* PA, bf16* MIX, const float* cw, int vcu, int tid) {
    const int r0 = 64 * vcu + 8 * (tid >> 6), c0 = 8 * (tid & 63);
    float w0[8], w1[8], w2[8];
#pragma unroll
    for (int e = 0; e < 8; ++e) { w0[e] = cw[c0 + e]; w1[e] = cw[512 + c0 + e]; w2[e] = cw[1024 + c0 + e]; }
    float p2[8], p1[8];
#pragma unroll
    for (int e = 0; e < 8; ++e) { p2[e] = 0.f; p1[e] = 0.f; }
    const int tseq = r0 % SEQ;
    if (tseq >= 2) {
        float a[8], b[8];
        unpack8(*(const v4u*)(PA + (size_t)(r0 - 2) * PA_P + 512 + c0), a); unpack8(*(const v4u*)(PA + (size_t)(r0 - 2) * PA_P + 1024 + c0), b);
#pragma unroll
        for (int e = 0; e < 8; ++e) p2[e] = a[e] * b[e];
        unpack8(*(const v4u*)(PA + (size_t)(r0 - 1) * PA_P + 512 + c0), a); unpack8(*(const v4u*)(PA + (size_t)(r0 - 1) * PA_P + 1024 + c0), b);
#pragma unroll
        for (int e = 0; e < 8; ++e) p1[e] = a[e] * b[e];
    }
#pragma unroll
    for (int i = 0; i < 8; ++i) {
        const size_t ro = (size_t)(r0 + i) * PA_P;
        float gb[8], a[8], b[8], p0[8];
        unpack8(*(const v4u*)(PA + ro + c0), gb); unpack8(*(const v4u*)(PA + ro + 512 + c0), a); unpack8(*(const v4u*)(PA + ro + 1024 + c0), b);
        float y[8];
#pragma unroll
        for (int e = 0; e < 8; ++e) { p0[e] = a[e] * b[e]; y[e] = gb[e] * (w0[e] * p2[e] + w1[e] * p1[e] + w2[e] * p0[e]); p2[e] = p1[e]; p1[e] = p0[e]; }
        v4u o; o.x = pk2(y[0], y[1]); o.y = pk2(y[2], y[3]); o.z = pk2(y[4], y[5]); o.w = pk2(y[6], y[7]);
        *(v4u*)(MIX + (size_t)(r0 + i) * MIX_P + c0) = o;
    }
}

__device__ __forceinline__ void glu_fixup(const float* SG, const float* SV, bf16* H, const float* cw, const float* cb, int pm, int tid) {
    for (int idx = tid; idx < 8 * 352; idx += NTHR) {
        const int rr = idx / 352, cc = idx % 352, k = rr >> 1, i = rr & 1, c0 = 8 * cc, B = 4 * pm + k, row = 64 * B + i;
        const bool first = (B % (SEQ / 64)) == 0;
#pragma unroll
        for (int hf = 0; hf < 2; ++hf) { const int c = c0 + 4 * hf; const f32x4 z = (f32x4){0.f, 0.f, 0.f, 0.f};
            const f32x4 g0 = *(const f32x4*)(SG + ((size_t)B * 4 + 2 + i) * DFF + c);
            const f32x4 g1 = i ? *(const f32x4*)(SG + ((size_t)B * 4 + 2) * DFF + c) : (first ? z : *(const f32x4*)(SG + ((size_t)(B - 1) * 4 + 1) * DFF + c));
            const f32x4 g2 = first ? z : (i ? *(const f32x4*)(SG + ((size_t)(B - 1) * 4 + 1) * DFF + c) : *(const f32x4*)(SG + ((size_t)(B - 1) * 4 + 0) * DFF + c));
            const f32x4 v = *(const f32x4*)(SV + ((size_t)B * 2 + i) * DFF + c);
            const f32x4 w0 = *(const f32x4*)(cw + c), w1 = *(const f32x4*)(cw + DFF + c), w2 = *(const f32x4*)(cw + 2 * DFF + c), bb = *(const f32x4*)(cb + c);
            const f32x4 pre = w0 * g2 + w1 * g1 + w2 * g0 + bb; f32x4 hv;
#pragma unroll
            for (int e = 0; e < 4; ++e) hv[e] = pre[e] * __builtin_amdgcn_rcpf(1.0f + __builtin_amdgcn_exp2f(-LOG2E * pre[e])) * v[e];
            v2u w; w.x = pk2(hv[0], hv[1]); w.y = pk2(hv[2], hv[3]); *(v2u*)(H + (size_t)row * DFF + c) = w; }
    }
}

__device__ __forceinline__ void fox_scan(const float* LF, float* C, int bh, LAS float* sh, int tid, int wave, int lane) {
    const int b = bh >> 3, h = bh & 7;
    float v[4];
#pragma unroll
    for (int j = 0; j < 4; ++j) v[j] = LF[(size_t)(b * SEQ + 4 * tid + j) * 8 + h];
    v[1] += v[0]; v[2] += v[1]; v[3] += v[2];
    float tot = v[3];
#pragma unroll
    for (int o = 1; o < 64; o <<= 1) { const float n = __shfl_up(tot, o); if (lane >= o) tot += n; }
    if (lane == 63) sh[wave] = tot;
    __syncthreads();
    float base = tot - v[3];
    for (int w = 0; w < wave; ++w) base += sh[w];
#pragma unroll
    for (int j = 0; j < 4; ++j) C[(size_t)bh * SEQ + 4 * tid + j] = base + v[j];
    __syncthreads();
}

namespace att {
typedef float f32x16 __attribute__((ext_vector_type(16)));
typedef short bf16x8 __attribute__((ext_vector_type(8)));
typedef short s16x4 __attribute__((ext_vector_type(4)));
constexpr int KP = 144, VP = 136;
constexpr int KBUF = 64 * KP, VBUF = 64 * VP;
constexpr int OFF_K = 0, OFF_V = 2 * KBUF, OFF_C = OFF_V + 2 * VBUF, OFF_FLAG = OFF_C + SEQ * 4, OFF_SH = OFF_FLAG + 64;
static_assert(OFF_C % 16 == 0, "c array alignment");
__device__ __forceinline__ int crow(int r, int hi) { return (r & 3) + 8 * (r >> 2) + 4 * hi; }
__device__ __forceinline__ float dpp_xor1(float v) { return __int_as_float(__builtin_amdgcn_update_dpp(0, __float_as_int(v), 0xB1, 0xf, 0xf, true)); }
__device__ __forceinline__ float dpp_xor2(float v) { return __int_as_float(__builtin_amdgcn_update_dpp(0, __float_as_int(v), 0x4E, 0xf, 0xf, true)); }
__device__ __forceinline__ float dpp_hmir(float v) { return __int_as_float(__builtin_amdgcn_update_dpp(0, __float_as_int(v), 0x141, 0xf, 0xf, true)); }
__device__ __forceinline__ float xhalf(float v, int hi) { const unsigned u = __float_as_uint(v); auto rr = __builtin_amdgcn_permlane32_swap(u, u, false, false); return __uint_as_float(hi ? rr[0] : rr[1]); }
__device__ __forceinline__ unsigned pkbf(float lo, float hi) { unsigned r; asm volatile("v_cvt_pk_bf16_f32 %0, %1, %2" : "=v"(r) : "v"(lo), "v"(hi)); return r; }

__device__ __forceinline__ void scan_to_lds(const float* LF, int b, int h, LAS unsigned char* lds, int tid, int wave, int lane) {
    LAS float* cL = (LAS float*)(lds + OFF_C); LAS float* sh = (LAS float*)(lds + OFF_SH);
    float v[4];
#pragma unroll
    for (int j = 0; j < 4; ++j) v[j] = LF[(size_t)(b * SEQ + 4 * tid + j) * 8 + h];
    v[1] += v[0]; v[2] += v[1]; v[3] += v[2];
    float tot = v[3];
#pragma unroll
    for (int o = 1; o < 64; o <<= 1) { const float n = __shfl_up(tot, o); if (lane >= o) tot += n; }
    if (lane == 63) sh[wave] = tot;
    __syncthreads();
    float base = tot - v[3];
    for (int w = 0; w < wave; ++w) base += sh[w];
#pragma unroll
    for (int j = 0; j < 4; ++j) cL[4 * tid + j] = (base + v[j]) * LOG2E;
    __syncthreads();
}

template <int MODE>
__device__ __forceinline__ void attn_unit(LAS unsigned char* lds, const bf16* Qg, const bf16* Kg, const bf16* Vg, bf16* Og, int qt,
                                          const float* gq, const float* gk, int tid, int wave, int lane) {
    const int r32 = lane & 31, hi = lane >> 5;
    const int NT = 4 * qt + 4;
    const int qabs = 256 * qt + 32 * wave + r32;
    const int dtile = 4 * qt + (wave >> 1);
    const int srow = tid >> 3, sch = tid & 7;
    bf16x8 qr[4];
    { float qf[4][8]; float ss = 0.f;
#pragma unroll
      for (int d0 = 0; d0 < 4; ++d0) { unpack8(*(const v4u*)(Qg + (size_t)qabs * PA_P + 16 * d0 + 8 * hi), qf[d0]);
#pragma unroll
          for (int e = 0; e < 8; ++e) ss += qf[d0][e] * qf[d0][e]; }
      float sc = 0.125f * LOG2E;
      if (MODE == 0) { ss += __shfl_xor(ss, 32); sc *= rsqrtf(ss * (1.0f / 64.0f) + NORM_EPS); }
#pragma unroll
      for (int d0 = 0; d0 < 4; ++d0) { v4u w;
          if (MODE == 0) { float g[8];
#pragma unroll
              for (int e = 0; e < 8; ++e) g[e] = gq[16 * d0 + 8 * hi + e] * sc;
              w.x = pkbf(qf[d0][0] * g[0], qf[d0][1] * g[1]); w.y = pkbf(qf[d0][2] * g[2], qf[d0][3] * g[3]); w.z = pkbf(qf[d0][4] * g[4], qf[d0][5] * g[5]); w.w = pkbf(qf[d0][6] * g[6], qf[d0][7] * g[7]);
          } else { w.x = pkbf(qf[d0][0] * sc, qf[d0][1] * sc); w.y = pkbf(qf[d0][2] * sc, qf[d0][3] * sc); w.z = pkbf(qf[d0][4] * sc, qf[d0][5] * sc); w.w = pkbf(qf[d0][6] * sc, qf[d0][7] * sc); }
          qr[d0] = __builtin_bit_cast(bf16x8, w); } }
    float gkr[8];
#pragma unroll
    for (int e = 0; e < 8; ++e) gkr[e] = (MODE == 0) ? gk[8 * sch + e] : 1.0f;
    const LAS float* cL = (const LAS float*)(lds + OFF_C);
    const float cq = (MODE == 0) ? cL[qabs] : 0.f;
    f32x16 o[2];
#pragma unroll
    for (int r = 0; r < 16; ++r) { o[0][r] = 0.f; o[1][r] = 0.f; }
    float mrun = 0.f, lrun = 0.f, P = 1.0f;
    v4u kreg, vreg; bool sb_done = false;
#define ATT_GLOAD(T) do { const size_t ro_ = (size_t)(64 * (T) + srow) * PA_P + 8 * sch; kreg = *(const v4u*)(Kg + ro_); vreg = *(const v4u*)(Vg + ro_); } while (0)
#define ATT_STAGE(buf) do { \
        if (MODE == 0) { float kf_[8]; unpack8(kreg, kf_); float s_ = 0.f; _Pragma("unroll") for (int e = 0; e < 8; ++e) s_ += kf_[e] * kf_[e]; \
            s_ += dpp_xor1(s_); s_ += dpp_xor2(s_); s_ += dpp_hmir(s_); const float rs_ = rsqrtf(s_ * (1.0f / 64.0f) + NORM_EPS); \
            kreg.x = pkbf(kf_[0] * rs_ * gkr[0], kf_[1] * rs_ * gkr[1]); kreg.y = pkbf(kf_[2] * rs_ * gkr[2], kf_[3] * rs_ * gkr[3]); \
            kreg.z = pkbf(kf_[4] * rs_ * gkr[4], kf_[5] * rs_ * gkr[5]); kreg.w = pkbf(kf_[6] * rs_ * gkr[6], kf_[7] * rs_ * gkr[7]); } \
        *(LAS v4u*)(lds + OFF_K + (buf) * KBUF + srow * KP + sch * 16) = kreg; \
        LAS unsigned short* vt_ = (LAS unsigned short*)(lds + OFF_V + (buf) * VBUF + (8 * sch) * VP + srow * 2); \
        vt_[0 * (VP / 2)] = (unsigned short)(vreg.x & 0xffffu); vt_[1 * (VP / 2)] = (unsigned short)(vreg.x >> 16); \
        vt_[2 * (VP / 2)] = (unsigned short)(vreg.y & 0xffffu); vt_[3 * (VP / 2)] = (unsigned short)(vreg.y >> 16); \
        vt_[4 * (VP / 2)] = (unsigned short)(vreg.z & 0xffffu); vt_[5 * (VP / 2)] = (unsigned short)(vreg.z >> 16); \
        vt_[6 * (VP / 2)] = (unsigned short)(vreg.w & 0xffffu); vt_[7 * (VP / 2)] = (unsigned short)(vreg.w >> 16); } while (0)
    int it0 = 0;
    if (MODE == 0) { const float cq0 = cL[256 * qt]; while (it0 < 4 * qt && cq0 - cL[64 * it0 + 63] < -130.0f * LOG2E) ++it0; }
    ATT_GLOAD(MODE ? NT - 1 : it0);
    ATT_STAGE(0);
    __syncthreads();
    for (int it = it0; it < NT; ++it) {
        const int tile = MODE ? NT - 1 - it : it, buf = (it - it0) & 1;
        const bool more = it + 1 < NT;
        if (more) ATT_GLOAD(MODE ? tile - 1 : tile + 1);
        if (tile <= dtile && !(MODE == 1 && sb_done)) {
            const int kv0 = 64 * tile;
            f32x16 p0, p1;
            if (MODE == 0) { const float cqm = cq - mrun;
#pragma unroll
                for (int g = 0; g < 4; ++g) { const f32x4 c0 = *(const LAS f32x4*)(cL + kv0 + 8 * g + 4 * hi), c1 = *(const LAS f32x4*)(cL + kv0 + 32 + 8 * g + 4 * hi);
#pragma unroll
                    for (int j = 0; j < 4; ++j) { p0[4 * g + j] = cqm - c0[j]; p1[4 * g + j] = cqm - c1[j]; } }
            } else {
#pragma unroll
                for (int r = 0; r < 16; ++r) { p0[r] = 0.f; p1[r] = 0.f; }
            }
            const LAS unsigned char* kb = lds + OFF_K + buf * KBUF + r32 * KP + hi * 16;
            const LAS unsigned char* vb = lds + OFF_V + buf * VBUF + r32 * VP + hi * 8;
            bf16x8 kf[8];
#pragma unroll
            for (int d0 = 0; d0 < 4; ++d0) { kf[2 * d0] = *(const LAS bf16x8*)(kb + d0 * 32); kf[2 * d0 + 1] = *(const LAS bf16x8*)(kb + 32 * KP + d0 * 32); }
#pragma unroll
            for (int d0 = 0; d0 < 4; ++d0) {
                p0 = __builtin_amdgcn_mfma_f32_32x32x16_bf16(kf[2 * d0], qr[d0], p0, 0, 0, 0);
                p1 = __builtin_amdgcn_mfma_f32_32x32x16_bf16(kf[2 * d0 + 1], qr[d0], p1, 0, 0, 0);
            }
            s16x4 vlo[8], vhi[8];
#pragma unroll
            for (int db = 0; db < 2; ++db)
#pragma unroll
                for (int ks = 0; ks < 4; ++ks) { vlo[db * 4 + ks] = *(const LAS s16x4*)(vb + db * 32 * VP + ks * 32); vhi[db * 4 + ks] = *(const LAS s16x4*)(vb + db * 32 * VP + ks * 32 + 16); }
            const bool diag = (tile == dtile);
            if (MODE == 0) {
                if (diag) {
#pragma unroll
                    for (int r = 0; r < 16; ++r) { const int kv = kv0 + crow(r, hi); if (kv > qabs) p0[r] = -1e30f; if (kv + 32 > qabs) p1[r] = -1e30f; }
                }
                float mx = fmaxf(p0[0], p1[0]);
#pragma unroll
                for (int r = 1; r < 16; ++r) mx = fmaxf(mx, fmaxf(p0[r], p1[r]));
                mx = fmaxf(mx, xhalf(mx, hi));
                if (__any(mx > 8.0f)) {
                    const float dl = fmaxf(mx, 0.f), alpha = __builtin_amdgcn_exp2f(-dl);
                    mrun += dl; lrun *= alpha;
#pragma unroll
                    for (int r = 0; r < 16; ++r) { p0[r] -= dl; p1[r] -= dl; o[0][r] *= alpha; o[1][r] *= alpha; }
                }
                float ls = 0.f;
#pragma unroll
                for (int r = 0; r < 16; ++r) { p0[r] = __builtin_amdgcn_exp2f(p0[r]); p1[r] = __builtin_amdgcn_exp2f(p1[r]); ls += p0[r] + p1[r]; }
                lrun += ls;
            } else {
                float carry = P;
#pragma unroll
                for (int blk = 1; blk >= 0; --blk) {
                    f32x16& pz = blk ? p1 : p0;
                    float u[16], x[16];
#pragma unroll
                    for (int r = 0; r < 16; ++r) { u[r] = __builtin_amdgcn_exp2f(fminf(pz[r], 115.0f)); x[r] = 1.0f + u[r]; }
                    if (diag) {
#pragma unroll
                        for (int r = 0; r < 16; ++r) { const bool act = (kv0 + 32 * blk + crow(r, hi)) < qabs; u[r] = act ? u[r] : 0.f; x[r] = act ? x[r] : 1.0f; }
                    }
                    float s[16], Gown[4], Gp[4], AP[4], AG[4];
#pragma unroll
                    for (int g = 0; g < 4; ++g) { s[4 * g + 3] = 1.0f; s[4 * g + 2] = x[4 * g + 3]; s[4 * g + 1] = s[4 * g + 2] * x[4 * g + 2]; s[4 * g] = s[4 * g + 1] * x[4 * g + 1]; Gown[g] = s[4 * g] * x[4 * g]; }
#pragma unroll
                    for (int g = 0; g < 4; ++g) Gp[g] = xhalf(Gown[g], hi);
                    AP[3] = carry; AP[2] = AP[3] * (Gown[3] * Gp[3]); AP[1] = AP[2] * (Gown[2] * Gp[2]); AP[0] = AP[1] * (Gown[1] * Gp[1]); carry = AP[0] * (Gown[0] * Gp[0]);
#pragma unroll
                    for (int g = 0; g < 4; ++g) AG[g] = hi ? AP[g] : AP[g] * Gp[g];
#pragma unroll
                    for (int r = 0; r < 16; ++r) pz[r] = u[r] * __builtin_amdgcn_rcpf(x[r] * (AG[r >> 2] * s[r]));
                }
                P = carry;
            }
            bf16x8 pb[4];
#pragma unroll
            for (int ks = 0; ks < 4; ++ks) { const f32x16& pz = (ks >> 1) ? p1 : p0; const int rb = 8 * (ks & 1);
                v4u w; w.x = pkbf(pz[rb + 0], pz[rb + 1]); w.y = pkbf(pz[rb + 2], pz[rb + 3]); w.z = pkbf(pz[rb + 4], pz[rb + 5]); w.w = pkbf(pz[rb + 6], pz[rb + 7]);
                pb[ks] = __builtin_bit_cast(bf16x8, w); }
#pragma unroll
            for (int ks = 0; ks < 4; ++ks)
#pragma unroll
                for (int db = 0; db < 2; ++db) {
                    const s16x4 lo = vlo[db * 4 + ks], hh = vhi[db * 4 + ks];
                    const bf16x8 a = (bf16x8){lo[0], lo[1], lo[2], lo[3], hh[0], hh[1], hh[2], hh[3]};
                    o[db] = __builtin_amdgcn_mfma_f32_32x32x16_bf16(a, pb[ks], o[db], 0, 0, 0);
                }
        }
        if (more) ATT_STAGE(buf ^ 1);
        if (MODE == 1) { const int dn_ = __all(P > 8.0e37f) ? 1 : 0; sb_done = dn_ != 0; if (lane == 0) ((LAS int*)(lds + OFF_FLAG))[(it & 1) * 8 + wave] = dn_; }
        __syncthreads();
        if (MODE == 1) { const LAS int* fl = (const LAS int*)(lds + OFF_FLAG) + (it & 1) * 8; int dn = 1;
#pragma unroll
            for (int w = 0; w < 8; ++w) dn &= fl[w];
            if (dn) break; }
    }
#undef ATT_GLOAD
#undef ATT_STAGE
    float inv = 1.0f;
    if (MODE == 0) { const float lt = lrun + __shfl_xor(lrun, 32); inv = 1.0f / lt; }
    bf16* orow = Og + (size_t)qabs * MIX_P;
#pragma unroll
    for (int db = 0; db < 2; ++db)
#pragma unroll
        for (int g = 0; g < 4; ++g) { v2u w; w.x = pkbf(o[db][4 * g] * inv, o[db][4 * g + 1] * inv); w.y = pkbf(o[db][4 * g + 2] * inv, o[db][4 * g + 3] * inv);
            *(v2u*)(orow + 32 * db + 8 * g + 4 * hi) = w; }
}

struct FoxState { bf16x8 qr0, qr1, qr2, qr3; f32x16 o0, o1; float cq, mrun, lrun; int qabs, dtile, it0; };
__device__ __forceinline__ void fox_setup(FoxState& s, const bf16* Qg, int qt, const float* gq, const LAS float* cL, int wave, int r32, int hi, float skip_thr) {
    s.qabs = 256 * qt + 32 * wave + r32; s.dtile = 4 * qt + (wave >> 1);
    int it0 = 0; { const float cq0 = cL[256 * qt]; while (it0 < 4 * qt && cq0 - cL[64 * it0 + 63] < skip_thr) ++it0; }
    s.it0 = it0;
    float qf[4][8]; float ss = 0.f;
#pragma unroll
    for (int d0 = 0; d0 < 4; ++d0) { unpack8(*(const v4u*)(Qg + (size_t)s.qabs * PA_P + 16 * d0 + 8 * hi), qf[d0]);
#pragma unroll
        for (int e = 0; e < 8; ++e) ss += qf[d0][e] * qf[d0][e]; }
    ss += __shfl_xor(ss, 32);
    const float sc = 0.125f * LOG2E * rsqrtf(ss * (1.0f / 64.0f) + NORM_EPS);
    bf16x8 q[4];
#pragma unroll
    for (int d0 = 0; d0 < 4; ++d0) { float g[8];
#pragma unroll
        for (int e = 0; e < 8; ++e) g[e] = gq[16 * d0 + 8 * hi + e] * sc;
        v4u w; w.x = pkbf(qf[d0][0] * g[0], qf[d0][1] * g[1]); w.y = pkbf(qf[d0][2] * g[2], qf[d0][3] * g[3]); w.z = pkbf(qf[d0][4] * g[4], qf[d0][5] * g[5]); w.w = pkbf(qf[d0][6] * g[6], qf[d0][7] * g[7]);
        q[d0] = __builtin_bit_cast(bf16x8, w); }
    s.qr0 = q[0]; s.qr1 = q[1]; s.qr2 = q[2]; s.qr3 = q[3];
    s.cq = cL[s.qabs]; s.mrun = 0.f; s.lrun = 0.f;
#pragma unroll
    for (int r = 0; r < 16; ++r) { s.o0[r] = 0.f; s.o1[r] = 0.f; }
}
__device__ __forceinline__ void fox_tile(FoxState& s, LAS unsigned char* lds, const LAS float* cL, int tile, int buf, int r32, int hi) {
    const int kv0 = 64 * tile;
    f32x16 p0, p1;
    { const float cqm = s.cq - s.mrun;
#pragma unroll
      for (int g = 0; g < 4; ++g) { const f32x4 c0 = *(const LAS f32x4*)(cL + kv0 + 8 * g + 4 * hi), c1 = *(const LAS f32x4*)(cL + kv0 + 32 + 8 * g + 4 * hi);
#pragma unroll
          for (int j = 0; j < 4; ++j) { p0[4 * g + j] = cqm - c0[j]; p1[4 * g + j] = cqm - c1[j]; } } }
    const LAS unsigned char* kb = lds + OFF_K + buf * KBUF + r32 * KP + hi * 16;
    const LAS unsigned char* vb = lds + OFF_V + buf * VBUF + r32 * VP + hi * 8;
    bf16x8 kf[8];
#pragma unroll
    for (int d0 = 0; d0 < 4; ++d0) { kf[2 * d0] = *(const LAS bf16x8*)(kb + d0 * 32); kf[2 * d0 + 1] = *(const LAS bf16x8*)(kb + 32 * KP + d0 * 32); }
    p0 = __builtin_amdgcn_mfma_f32_32x32x16_bf16(kf[0], s.qr0, p0, 0, 0, 0); p1 = __builtin_amdgcn_mfma_f32_32x32x16_bf16(kf[1], s.qr0, p1, 0, 0, 0);
    p0 = __builtin_amdgcn_mfma_f32_32x32x16_bf16(kf[2], s.qr1, p0, 0, 0, 0); p1 = __builtin_amdgcn_mfma_f32_32x32x16_bf16(kf[3], s.qr1, p1, 0, 0, 0);
    p0 = __builtin_amdgcn_mfma_f32_32x32x16_bf16(kf[4], s.qr2, p0, 0, 0, 0); p1 = __builtin_amdgcn_mfma_f32_32x32x16_bf16(kf[5], s.qr2, p1, 0, 0, 0);
    p0 = __builtin_amdgcn_mfma_f32_32x32x16_bf16(kf[6], s.qr3, p0, 0, 0, 0); p1 = __builtin_amdgcn_mfma_f32_32x32x16_bf16(kf[7], s.qr3, p1, 0, 0, 0);
    s16x4 vlo[8], vhi[8];
#pragma unroll
    for (int db = 0; db < 2; ++db)
#pragma unroll
        for (int ks = 0; ks < 4; ++ks) { vlo[db * 4 + ks] = *(const LAS s16x4*)(vb + db * 32 * VP + ks * 32); vhi[db * 4 + ks] = *(const LAS s16x4*)(vb + db * 32 * VP + ks * 32 + 16); }
    if (tile == s.dtile) {
#pragma unroll
        for (int r = 0; r < 16; ++r) { const int kv = kv0 + crow(r, hi); if (kv > s.qabs) p0[r] = -1e30f; if (kv + 32 > s.qabs) p1[r] = -1e30f; }
    }
    float mx = fmaxf(p0[0], p1[0]);
#pragma unroll
    for (int r = 1; r < 16; ++r) mx = fmaxf(mx, fmaxf(p0[r], p1[r]));
    mx = fmaxf(mx, xhalf(mx, hi));
    if (__any(mx > 8.0f)) {
        const float dl = fmaxf(mx, 0.f), alpha = __builtin_amdgcn_exp2f(-dl);
        s.mrun += dl; s.lrun *= alpha;
#pragma unroll
        for (int r = 0; r < 16; ++r) { p0[r] -= dl; p1[r] -= dl; s.o0[r] *= alpha; s.o1[r] *= alpha; }
    }
    float ls = 0.f;
#pragma unroll
    for (int r = 0; r < 16; ++r) { p0[r] = __builtin_amdgcn_exp2f(p0[r]); p1[r] = __builtin_amdgcn_exp2f(p1[r]); ls += p0[r] + p1[r]; }
    s.lrun += ls;
    bf16x8 pb[4];
#pragma unroll
    for (int ks = 0; ks < 4; ++ks) { const f32x16& pz = (ks >> 1) ? p1 : p0; const int rb = 8 * (ks & 1);
        v4u w; w.x = pkbf(pz[rb + 0], pz[rb + 1]); w.y = pkbf(pz[rb + 2], pz[rb + 3]); w.z = pkbf(pz[rb + 4], pz[rb + 5]); w.w = pkbf(pz[rb + 6], pz[rb + 7]);
        pb[ks] = __builtin_bit_cast(bf16x8, w); }
#pragma unroll
    for (int ks = 0; ks < 4; ++ks) {
        { const s16x4 lo = vlo[ks], hh = vhi[ks]; const bf16x8 a = (bf16x8){lo[0], lo[1], lo[2], lo[3], hh[0], hh[1], hh[2], hh[3]}; s.o0 = __builtin_amdgcn_mfma_f32_32x32x16_bf16(a, pb[ks], s.o0, 0, 0, 0); }
        { const s16x4 lo = vlo[4 + ks], hh = vhi[4 + ks]; const bf16x8 a = (bf16x8){lo[0], lo[1], lo[2], lo[3], hh[0], hh[1], hh[2], hh[3]}; s.o1 = __builtin_amdgcn_mfma_f32_32x32x16_bf16(a, pb[ks], s.o1, 0, 0, 0); }
    }
}
__device__ __forceinline__ void fox_store(const FoxState& s, bf16* Og, int hi) {
    const float lt = s.lrun + __shfl_xor(s.lrun, 32), inv = 1.0f / lt;
    bf16* orow = Og + (size_t)s.qabs * MIX_P;
#pragma unroll
    for (int g = 0; g < 4; ++g) { v2u w; w.x = pkbf(s.o0[4 * g] * inv, s.o0[4 * g + 1] * inv); w.y = pkbf(s.o0[4 * g + 2] * inv, s.o0[4 * g + 3] * inv); *(v2u*)(orow + 8 * g + 4 * hi) = w; }
#pragma unroll
    for (int g = 0; g < 4; ++g) { v2u w; w.x = pkbf(s.o1[4 * g] * inv, s.o1[4 * g + 1] * inv); w.y = pkbf(s.o1[4 * g + 2] * inv, s.o1[4 * g + 3] * inv); *(v2u*)(orow + 32 + 8 * g + 4 * hi) = w; }
}
__device__ __forceinline__ void fox_pair(LAS unsigned char* lds, const bf16* Qg, const bf16* Kg, const bf16* Vg, bf16* Og, int qtA, int qtB,
                                         const float* gq, const float* gk, int tid, int wave, int lane) {
    const int r32 = lane & 31, hi = lane >> 5, srow = tid >> 3, sch = tid & 7;
    const LAS float* cL = (const LAS float*)(lds + OFF_C);
    FoxState A, B;
    float gqm = fabsf(gq[lane]), gkm = fabsf(gk[lane]);
#pragma unroll
    for (int o_ = 1; o_ < 64; o_ <<= 1) { gqm = fmaxf(gqm, __shfl_xor(gqm, o_)); gkm = fmaxf(gkm, __shfl_xor(gkm, o_)); }
    const float skip_thr = -(2.0f * 8.0f * gqm * gkm + 40.0f) * LOG2E;
    int itA0 = 0; { const float cq0 = cL[256 * qtA]; while (itA0 < 4 * qtA && cq0 - cL[64 * itA0 + 63] < skip_thr) ++itA0; }
    v4u kreg, vreg;
    { const size_t ro_ = (size_t)(64 * itA0 + srow) * PA_P + 8 * sch; kreg = *(const v4u*)(Kg + ro_); vreg = *(const v4u*)(Vg + ro_); }
    fox_setup(A, Qg, qtA, gq, cL, wave, r32, hi, skip_thr);
    fox_setup(B, Qg, qtB, gq, cL, wave, r32, hi, skip_thr);
    const int lastA = 4 * qtA + 3, lastB = 4 * qtB + 3;
    const int jump = (B.it0 > lastA + 1) ? B.it0 : lastA + 1;
    float gkr[8];
#pragma unroll
    for (int e = 0; e < 8; ++e) gkr[e] = gk[8 * sch + e];
#define FP_GLOAD(T) do { const size_t ro_ = (size_t)(64 * (T) + srow) * PA_P + 8 * sch; kreg = *(const v4u*)(Kg + ro_); vreg = *(const v4u*)(Vg + ro_); } while (0)
#define FP_STAGE(buf) do { \
        float kf_[8]; unpack8(kreg, kf_); float s_ = 0.f; _Pragma("unroll") for (int e = 0; e < 8; ++e) s_ += kf_[e] * kf_[e]; \
        s_ += dpp_xor1(s_); s_ += dpp_xor2(s_); s_ += dpp_hmir(s_); const float rs_ = rsqrtf(s_ * (1.0f / 64.0f) + NORM_EPS); \
        v4u kn_; kn_.x = pkbf(kf_[0] * rs_ * gkr[0], kf_[1] * rs_ * gkr[1]); kn_.y = pkbf(kf_[2] * rs_ * gkr[2], kf_[3] * rs_ * gkr[3]); \
        kn_.z = pkbf(kf_[4] * rs_ * gkr[4], kf_[5] * rs_ * gkr[5]); kn_.w = pkbf(kf_[6] * rs_ * gkr[6], kf_[7] * rs_ * gkr[7]); \
        *(LAS v4u*)(lds + OFF_K + (buf) * KBUF + srow * KP + sch * 16) = kn_; \
        LAS unsigned short* vt_ = (LAS unsigned short*)(lds + OFF_V + (buf) * VBUF + (8 * sch) * VP + srow * 2); \
        vt_[0 * (VP / 2)] = (unsigned short)(vreg.x & 0xffffu); vt_[1 * (VP / 2)] = (unsigned short)(vreg.x >> 16); \
        vt_[2 * (VP / 2)] = (unsigned short)(vreg.y & 0xffffu); vt_[3 * (VP / 2)] = (unsigned short)(vreg.y >> 16); \
        vt_[4 * (VP / 2)] = (unsigned short)(vreg.z & 0xffffu); vt_[5 * (VP / 2)] = (unsigned short)(vreg.z >> 16); \
        vt_[6 * (VP / 2)] = (unsigned short)(vreg.w & 0xffffu); vt_[7 * (VP / 2)] = (unsigned short)(vreg.w >> 16); } while (0)
    int t = A.it0, buf = 0;
    FP_STAGE(0);
    __syncthreads();
    while (t <= lastB) {
        const int tn = (t == lastA) ? jump : t + 1;
        const bool more = tn <= lastB;
        if (more) FP_GLOAD(tn);
        if (t <= A.dtile) fox_tile(A, lds, cL, t, buf, r32, hi);
        if (t >= B.it0 && t <= B.dtile) fox_tile(B, lds, cL, t, buf, r32, hi);
        if (more) FP_STAGE(buf ^ 1);
        __syncthreads();
        t = tn; buf ^= 1;
    }
#undef FP_GLOAD
#undef FP_STAGE
    fox_store(A, Og, hi); fox_store(B, Og, hi);
}
}

#define XB_TMO      128
#define XB_XCNT(j)  (256  + 64 * (j))
#define XB_XSUB(j)  (1280 + 64 * (j))
#define XB_XGEN(j)  (2304 + 64 * (j))
#define XB_TOP      3328
#define XB_TOPGEN   3392
#define XCD_BAR_WORDS 3456
#define XB_SPIN_CAP (1u << 18)

__device__ __forceinline__ unsigned xb_ld(unsigned* p)              { return __hip_atomic_load(p, __ATOMIC_RELAXED, __HIP_MEMORY_SCOPE_AGENT); }
__device__ __forceinline__ unsigned xb_add(unsigned* p, unsigned v) { return __hip_atomic_fetch_add(p, v, __ATOMIC_RELAXED, __HIP_MEMORY_SCOPE_AGENT); }
__device__ __forceinline__ unsigned xb_xcc_id() { return (unsigned)__builtin_amdgcn_s_getreg((3 << 11) | 20) & 0xFu; }
#define XB_SPIN(cond, bar) do { unsigned _sp = 0; while (cond) { __builtin_amdgcn_s_sleep(1); \
    if ((++_sp & 255u) == 0u) { if (xb_ld(&(bar)[XB_TMO])) break; if (_sp > XB_SPIN_CAP) { atomicAdd(&(bar)[XB_TMO], 1u); break; } } } } while (0)

struct XcdBarrier {
    unsigned* bar; unsigned x;
    volatile LAS unsigned* st;
};

__device__ __forceinline__ XcdBarrier xcd_barrier_post(unsigned* bar, volatile LAS unsigned* st) {
    XcdBarrier b; b.bar = bar; b.x = xb_xcc_id(); b.st = st;
    if (threadIdx.x == 0) (void)xb_add(&bar[XB_XCNT(b.x)], 1u);
    return b;
}
__device__ __forceinline__ void xcd_barrier_complete(unsigned* bar, unsigned x, unsigned& nloc, unsigned& nx) {
    const unsigned G = gridDim.x * gridDim.y * gridDim.z;
    unsigned sum, cnt, mine, sp = 0u;
    for (;;) {
        sum = 0u; cnt = 0u; mine = 0u;
#pragma unroll
        for (unsigned j = 0; j < 16; ++j) { const unsigned c = xb_ld(&bar[XB_XCNT(j)]); sum += c; cnt += (c > 0u) ? 1u : 0u; mine = (j == x) ? c : mine; }
        if (sum == G) break;
        __builtin_amdgcn_s_sleep(1);
        if ((++sp & 255u) == 0u) { if (xb_ld(&bar[XB_TMO])) break; if (sp > XB_SPIN_CAP) { atomicAdd(&bar[XB_TMO], 1u); break; } }
    }
    nloc = mine > 0u ? mine : 1u; nx = cnt > 0u ? cnt : 1u;
}

__device__ __forceinline__ void xcd_barrier(const XcdBarrier& b) {
    asm volatile("s_waitcnt vmcnt(0)" ::: "memory");
    __syncthreads();
    if (threadIdx.x == 0) {
        unsigned* bar = b.bar; unsigned bxx = b.x; asm volatile("" : "+s"(bar), "+s"(bxx));
        __builtin_amdgcn_s_waitcnt(0);
        unsigned nloc = b.st[0], nx = b.st[1];
        if (nloc == 0u) { xcd_barrier_complete(bar, bxx, nloc, nx); b.st[0] = nloc; b.st[1] = nx; }
        const unsigned old = xb_add(&bar[XB_XSUB(bxx)], 1u);
        const unsigned gen = old / nloc;
        if (old + 1u == (gen + 1u) * nloc) {
            __builtin_amdgcn_fence(__ATOMIC_RELEASE, "agent");
            asm volatile("s_waitcnt vmcnt(0)" ::: "memory");
            const unsigned og = xb_add(&bar[XB_TOP], 1u);
            const unsigned tg = og / nx;
            if (og + 1u == (tg + 1u) * nx) xb_add(&bar[XB_TOPGEN], 1u);
            else XB_SPIN(xb_ld(&bar[XB_TOPGEN]) == tg, bar);
            __builtin_amdgcn_fence(__ATOMIC_ACQUIRE, "agent");
            xb_add(&bar[XB_XGEN(bxx)], 1u);
            asm volatile("s_waitcnt vmcnt(0)" ::: "memory");
        } else {
            XB_SPIN(xb_ld(&bar[XB_XGEN(bxx)]) == gen, bar);
            __builtin_amdgcn_fence(__ATOMIC_ACQUIRE, "agent");
            asm volatile("s_waitcnt vmcnt(0)" ::: "memory");
        }
    }
    __syncthreads();
}

#define CW_XT    4096
#define CW_FLAG  4608
#define CW_LOC(x) (5120 + 64 * (x))
#define CTL_MEMSET_BYTES 32768
__device__ __forceinline__ void xcd_local_barrier(unsigned* ctl, int grp, unsigned& lgen, const bool is_t0) {
    asm volatile("s_waitcnt vmcnt(0) lgkmcnt(0)" ::: "memory");
    __syncthreads();
    if (is_t0) {
        asm volatile("" : "+s"(ctl));
        unsigned* cnt = ctl + CW_LOC(grp);
        (void)xb_add(cnt, 1u);
        const unsigned target = (lgen + 1u) * 32u;
        XB_SPIN(xb_ld(cnt) < target, ctl);
        __builtin_amdgcn_fence(__ATOMIC_ACQUIRE, "agent");
        asm volatile("s_waitcnt vmcnt(0)" ::: "memory");
    }
    lgen += 1u;
    __syncthreads();
}

__device__ __forceinline__ const Params* kargs() { const Params* q = (const Params*)__builtin_amdgcn_kernarg_segment_ptr(); asm volatile("" : "+s"(q)); return q; }
#define WSP(T, off) ((T*)(P->ws + (off)))
#define CGSYNC() do { asm volatile("s_waitcnt vmcnt(0) lgkmcnt(0)" ::: "memory"); __syncthreads(); \
    if (wave == 0) { __builtin_amdgcn_fence(__ATOMIC_RELEASE, "agent"); asm volatile("s_waitcnt vmcnt(0)" ::: "memory"); } \
    cg::this_grid().sync(); \
    if (wave == 0) { __builtin_amdgcn_fence(__ATOMIC_ACQUIRE, "agent"); asm volatile("s_waitcnt vmcnt(0)" ::: "memory"); } \
    __syncthreads(); } while (0)
#define GSYNC_GLOBAL() do { asm volatile("s_waitcnt lgkmcnt(0)" ::: "memory"); xcd_barrier(xbar); } while (0)
#define GSYNC() do { if (loc_mode) xcd_local_barrier(ctlw, bx & 7, lgen, threadIdx.x == 0); else GSYNC_GLOBAL(); } while (0)
__global__ void __launch_bounds__(NTHR, 2) fwd_megakernel(Params p_arg) {
    extern __shared__ __attribute__((aligned(16))) unsigned char lds_raw[];
    LAS unsigned char* lds = (LAS unsigned char*)lds_raw;
    const int tid = threadIdx.x, lane = tid & 63, wave = __builtin_amdgcn_readfirstlane(tid >> 6);
    const int G = gridDim.x, bx = blockIdx.x;
    const int vcu = (G % 8 == 0) ? (bx % 8) * (G / 8) + bx / 8 : bx;

    volatile LAS unsigned* xst = (volatile LAS unsigned*)(lds + LDS_XB_OFF);
    if (tid < 4) xst[tid] = 0u;
    __syncthreads();
    const XcdBarrier xbar = xcd_barrier_post((unsigned*)(p_arg.ws + WS_BAR), xst);
    unsigned* ctlw = (unsigned*)(p_arg.ws + WS_BAR);
    if (tid == 0) __hip_atomic_store(ctlw + CW_XT + bx, xbar.x + 1u, __ATOMIC_RELAXED, __HIP_MEMORY_SCOPE_AGENT);
    { const Params* P = &p_arg; prologue(*P, lds, vcu, G, wave, lane, tid); }
    if (p_arg.ws == nullptr) CGSYNC();
    GSYNC_GLOBAL();
    if (wave == 0) { bool bad = false;
        if (G == 256) { if (lane < 32) bad = __hip_atomic_load(ctlw + CW_XT + (bx & 7) + 8 * lane, __ATOMIC_RELAXED, __HIP_MEMORY_SCOPE_AGENT) != xbar.x + 1u; } else bad = true;
        if (__any(bad) && lane == 0) (void)xb_add(ctlw + CW_FLAG, 1u); }
    GSYNC_GLOBAL();
    const bool loc_mode = __builtin_amdgcn_readfirstlane((int)__hip_atomic_load(ctlw + CW_FLAG, __ATOMIC_RELAXED, __HIP_MEMORY_SCOPE_AGENT)) == 0;
    unsigned lgen = 0u;

#pragma unroll 1
    for (int l = 0; l < DEPTH; ++l) {
        { const Params* P = &p_arg; const unsigned char* wl = P->ws + WS_W + (size_t)l * W_LAYER;
          pg8::Gemm g{WSP(bf16, WS_XB), (const bf16*)(wl + W_IN), MTOK, NIN, DM, DM, DM, 1 << 20, 0, 16}; pg8::StaticOrder S; S.init(MTOK, NIN, G, bx);
          pg8::EpiIn E{WSP(bf16, WS_PA), WSP(bf16, WS_G), WSP(float, WS_LF), WSP(unsigned long long, WS_SSQ) + (size_t)(2 * l) * MTOK, P->gate_bias + l * 3072, P->fox_f_bias + l * 8};
          pg8::gemm_phase<pg8::EpiIn, pg8::StaticOrder, true, true>(lds, g, S, E); }
        GSYNC();
        { const Params* P = &p_arg; int tid = threadIdx.x; asm volatile("" : "+v"(tid)); const int lane = tid & 63;
          for (int v = vcu; v < MTOK / 64; v += G) conv_mixer(WSP(bf16, WS_PA), WSP(bf16, WS_MIX), P->conv_w + l * 1536, v, tid);
#pragma unroll 1
          for (int wv = vcu; wv < 256; wv += G) {
            const int bh = wv >> 2, pr = wv & 3, b = bh >> 3, h = bh & 7;
            att::scan_to_lds(WSP(float, WS_LF), b, h, lds, tid, wave, lane);
            const bf16* PAb = WSP(bf16, WS_PA) + (size_t)b * SEQ * PA_P + h * 64; bf16* MIXb = WSP(bf16, WS_MIX) + (size_t)b * SEQ * MIX_P + h * 64;
            att::fox_pair(lds, PAb + 1536, PAb + 2048, PAb + 2560, MIXb + 512, pr, 7 - pr, P->fox_q_norm_g + l * 64, P->fox_k_norm_g + l * 64, tid, wave, lane);
#pragma unroll 1
            for (int k = 0; k < 2; ++k) att::attn_unit<1>(lds, PAb + 3072, PAb + 3584, PAb + 4096, MIXb + 1024, 2 * (3 - pr) + k, nullptr, nullptr, tid, wave, lane);
          } }
        GSYNC();
        { const Params* P = &p_arg; const unsigned char* wl = P->ws + WS_W + (size_t)l * W_LAYER;
          pg8::Gemm g{WSP(bf16, WS_MIX), (const bf16*)(wl + W_P), MTOK, DM, 1536, MIX_P, 1536, 1 << 20, 0, 24}; pg8::StaticOrder S; S.init(MTOK, DM, G, bx);
          pg8::EpiMerge E{WSP(bf16, WS_YG), WSP(bf16, WS_G)};
          pg8::gemm_phase<pg8::EpiMerge, pg8::StaticOrder, true, true>(lds, g, S, E); }
        GSYNC();
        { const Params* P = &p_arg; const unsigned char* wl = P->ws + WS_W + (size_t)l * W_LAYER;
          pg8::Gemm g{WSP(bf16, WS_YG), (const bf16*)(wl + W_OUT), MTOK, DM, DM, DM, DM, 1 << 20, 0, 16}; pg8::StaticOrder S; S.init(MTOK, DM, G, bx);
          pg8::EpiRes E{l == 0 ? P->x : P->out, P->out, WSP(bf16, WS_XB), WSP(unsigned long long, WS_SSQ) + (size_t)(2 * l + 1) * MTOK};
          pg8::gemm_phase<pg8::EpiRes, pg8::StaticOrder, true, true>(lds, g, S, E); }
        GSYNC();
        { const Params* P = &p_arg; const unsigned char* wl = P->ws + WS_W + (size_t)l * W_LAYER;
          pg8::Gemm g{WSP(bf16, WS_XB), (const bf16*)(wl + W_UP), MTOK, NUP, DM, DM, DM, 1 << 20, 0, 16}; pg8::StaticOrder S; S.init(MTOK, NUP, G, bx);
          pg8::EpiGlu E{WSP(bf16, WS_H), WSP(float, WS_SG), WSP(float, WS_SV), WSP(unsigned long long, WS_SSQ) + (size_t)(2 * l + 1) * MTOK, P->ffn_conv_w + l * 3 * DFF, P->ffn_conv_b + l * DFF};
          pg8::gemm_phase<pg8::EpiGlu, pg8::StaticOrder, true, true>(lds, g, S, E); }
        GSYNC();
        { const Params* P = &p_arg; const unsigned char* wl = P->ws + WS_W + (size_t)l * W_LAYER;
          pg8::Gemm g{WSP(bf16, WS_H), (const bf16*)(wl + W_DOWN), MTOK, DM, DFF, DFF, DFF, 1 << 20, 0, 44}; pg8::StaticOrder S; S.init(MTOK, DM, G, bx);
          { int tid = threadIdx.x; asm volatile("" : "+v"(tid)); pg8::Unit u;
            for (int i = 0; S.next(i, u); ++i) glu_fixup(WSP(float, WS_SG), WSP(float, WS_SV), WSP(bf16, WS_H), P->ffn_conv_w + l * 3 * DFF, P->ffn_conv_b + l * DFF, u.pm, tid);
            asm volatile("s_waitcnt vmcnt(0)" ::: "memory"); __syncthreads(); }
          const bool lastl = (l == DEPTH - 1);
          pg8::EpiRes E{P->out, P->out, lastl ? nullptr : WSP(bf16, WS_XB), lastl ? nullptr : WSP(unsigned long long, WS_SSQ) + (size_t)(2 * l + 2) * MTOK};
          pg8::gemm_phase<pg8::EpiRes, pg8::StaticOrder, true, true>(lds, g, S, E); }
        GSYNC();
    }
}

extern "C" void kernel_launch(void* const* d_in, const int* in_sizes, int n_in, void* d_out, int out_size, void* d_ws, size_t ws_size, hipStream_t stream) {
    static int grid = 0;
    if (grid == 0) {
        int dev = 0, cus = 0, per_cu = 0;
        hipGetDevice(&dev);
        hipDeviceGetAttribute(&cus, hipDeviceAttributeMultiprocessorCount, dev);
        hipFuncSetAttribute((const void*)fwd_megakernel, hipFuncAttributeMaxDynamicSharedMemorySize, LDS_BYTES);
        hipOccupancyMaxActiveBlocksPerMultiprocessor(&per_cu, (const void*)fwd_megakernel, NTHR, LDS_BYTES);
        if (per_cu < 1) per_cu = 1;
        grid = cus * 1;
        if (ws_size < WS_END) fprintf(stderr, "kernel_launch: workspace too small (%zu < %zu)\n", ws_size, (size_t)WS_END);
    }
    Params p{};
    p.x = (const float*)d_in[0]; p.norm1_g = (const float*)d_in[1]; p.w_in = (const float*)d_in[2]; p.fox_f_bias = (const float*)d_in[3];
    p.gate_bias = (const float*)d_in[4]; p.conv_w = (const float*)d_in[5]; p.fox_q_norm_g = (const float*)d_in[6]; p.fox_k_norm_g = (const float*)d_in[7];
    p.w_proj_conv = (const float*)d_in[8]; p.w_proj_fox = (const float*)d_in[9]; p.w_proj_sb = (const float*)d_in[10]; p.w_out = (const float*)d_in[11];
    p.norm2_g = (const float*)d_in[12]; p.w_up = (const float*)d_in[13]; p.ffn_conv_w = (const float*)d_in[14]; p.ffn_conv_b = (const float*)d_in[15];
    p.w_down = (const float*)d_in[16]; p.out = (float*)d_out; p.ws = (unsigned char*)d_ws;
    (void)hipMemsetAsync((char*)d_ws + WS_BAR, 0, CTL_MEMSET_BYTES, stream);
    void* args[] = {&p};
    hipError_t e = hipLaunchCooperativeKernel((const void*)fwd_megakernel, dim3(grid), dim3(NTHR), args, LDS_BYTES, stream);
    if (e != hipSuccess) fprintf(stderr, "cooperative launch failed: %s (grid %d)\n", hipGetErrorString(e), grid);
}
```

```cpp
#include <hip/hip_runtime.h>
#include <hip/hip_cooperative_groups.h>
#include <cstdio>
#include <cstdint>
namespace cg = cooperative_groups;

constexpr int DM = 1024, BATCH = 8, SEQ = 2048, DEPTH = 4, MTOK = BATCH * SEQ;
constexpr int DIN = 7688, NIN = 7936, DFF = 2816, NUP = 2 * DFF;
constexpr int PA_P = 4608, G_P = 3072, MIX_P = 1536;
constexpr float NORM_EPS = 1e-6f;
constexpr float LOG2E = 1.4426950408889634f;
constexpr float SSQ_SCALE = 1048576.0f, SSQ_INV = 1.0f / 1048576.0f;

namespace pg8 {
#define PG8_LAS __attribute__((address_space(3)))
typedef unsigned short bf16_t;
typedef short bf16x8 __attribute__((ext_vector_type(8)));
typedef float f32x4 __attribute__((ext_vector_type(4)));
typedef unsigned u32x4 __attribute__((ext_vector_type(4)));
typedef unsigned u32x2 __attribute__((ext_vector_type(2)));
constexpr int BM = 256, BK = 64, HALF = 128, HTB = HALF * BK * 2  , STAGE_BYTES = 8 * HTB, NXCD = 8, WGM = 8;

__host__ __device__ __forceinline__ int lds_byte(int r, int c) { const int st = (r >> 4) * 2 + (c >> 5), rr = r & 15, cc = c & 31, ob = rr * 64 + cc * 2; return st * 1024 + (ob ^ (((ob >> 9) & 1) << 5)); }
__host__ __device__ __forceinline__ void stage_rc(int b, int& R, int& C) { const int st = b / 1024, sb = b % 1024, swz = sb ^ (((sb >> 9) & 1) << 5); R = (st >> 1) * 16 + swz / 64; C = (st & 1) * 32 + (swz % 64) / 2; }
__host__ __device__ __forceinline__ int perm32(int rho) { const int n = rho >> 4, i = rho & 15; return 8 * (i >> 2) + 4 * n + (i & 3); }

struct Unit { int pm, pn; };
struct Gemm { const bf16_t* A; const bf16_t* Bt; int M, N, K, lda, ldb, a_div, a_colstep, nbt; };

struct StaticOrder {
    int nM, nN, nwg, G, c;
    __host__ __device__ void init(int M, int N, int G_, int c_) { nM = M / BM; nN = N / BM; nwg = nM * nN; G = G_; c = c_; }
    __host__ __device__ bool next(int i, Unit& u) const {
        const long L = (long)i * G + c; if (L >= nwg) return false;
        int wgid = (int)L; { const int q = nwg / NXCD, r = nwg % NXCD, xcd = wgid % NXCD, off = wgid / NXCD; wgid = (xcd < r ? xcd * (q + 1) : r * (q + 1) + (xcd - r) * q) + off; }
        const int nig = WGM * nN, gid = wgid / nig, fm = gid * WGM, gsz = (nM - fm) < WGM ? (nM - fm) : WGM;
        u.pm = fm + ((wgid % nig) % gsz); u.pn = (wgid % nig) / gsz; return true;
    }
    __device__ __forceinline__ void a_ready(const Unit&) const {}
    __device__ __forceinline__ void done(const Unit&) const {}
};


__device__ __forceinline__ unsigned cvt_pk_bf16(float lo, float hi) { unsigned r; asm volatile("v_cvt_pk_bf16_f32 %0, %1, %2" : "=v"(r) : "v"(lo), "v"(hi)); return r; }
__device__ __forceinline__ float bflo(unsigned u) { return __uint_as_float(u << 16); }
__device__ __forceinline__ float bfhi(unsigned u) { return __uint_as_float(u & 0xffff0000u); }
__device__ __forceinline__ float sigmoidf_(float x) { return __builtin_amdgcn_rcpf(1.0f + __expf(-x)); }

struct EpiIn {
    static constexpr bool PERM = true, AFTER_DRAIN = false; static constexpr int HOOK_EVERY = 0;
    bf16_t* PA; bf16_t* G; float* LF; const unsigned long long* ssq; const float* gbias; const float* fbias;
    __device__ __forceinline__ void operator()(const f32x4 (&acc)[2][2][4][2], const Unit& u, int wr, int wc, int fr, int fq) const {
        const int row0 = u.pm * BM + wr * 64 + fr;
        const int col0 = u.pn * BM + wc * 32 + 8 * fq;
        unsigned long long sq[2][4];
#pragma unroll
        for (int ai = 0; ai < 2; ++ai)
#pragma unroll
            for (int m = 0; m < 4; ++m) sq[ai][m] = ssq[row0 + ai * HALF + m * 16];
        const bool gate = (u.pn >= 18) && (u.pn < 30);
        float rs[2][4];
#pragma unroll
        for (int ai = 0; ai < 2; ++ai)
#pragma unroll
            for (int m = 0; m < 4; ++m) rs[ai][m] = rsqrtf((float)sq[ai][m] * (SSQ_INV / DM) + NORM_EPS);
        if (u.pn < 30) {
            bf16_t* base = gate ? G + (col0 - PA_P) : PA + col0; const int ldc = gate ? G_P : PA_P;
#pragma unroll
            for (int bj = 0; bj < 2; ++bj) {
                f32x4 b0 = (f32x4){0.f, 0.f, 0.f, 0.f}, b1 = b0;
                if (gate) { b0 = *(const f32x4*)(gbias + (col0 - PA_P) + bj * HALF); b1 = *(const f32x4*)(gbias + (col0 - PA_P) + bj * HALF + 4); }
#pragma unroll
                for (int ai = 0; ai < 2; ++ai)
#pragma unroll
                    for (int m = 0; m < 4; ++m) { const int row = row0 + ai * HALF + m * 16;
                        f32x4 v0 = acc[ai][bj][m][0] * rs[ai][m] + b0, v1 = acc[ai][bj][m][1] * rs[ai][m] + b1;
                        if (gate) {
#pragma unroll
                            for (int e = 0; e < 4; ++e) { v0[e] = sigmoidf_(v0[e]); v1[e] = sigmoidf_(v1[e]); } }
                        u32x4 w; w.x = cvt_pk_bf16(v0[0], v0[1]); w.y = cvt_pk_bf16(v0[2], v0[3]); w.z = cvt_pk_bf16(v1[0], v1[1]); w.w = cvt_pk_bf16(v1[2], v1[3]);
                        *(u32x4*)(base + (size_t)row * ldc + bj * HALF) = w; }
            }
        } else {
            if (wc == 0 && fq == 0) {
#pragma unroll
                for (int ai = 0; ai < 2; ++ai)
#pragma unroll
                    for (int m = 0; m < 4; ++m) { const int row = row0 + ai * HALF + m * 16;
                        f32x4 v0 = acc[ai][0][m][0] * rs[ai][m] + *(const f32x4*)(fbias), v1 = acc[ai][0][m][1] * rs[ai][m] + *(const f32x4*)(fbias + 4);
#pragma unroll
                        for (int e = 0; e < 4; ++e) { v0[e] = fminf(v0[e], 0.f) - __logf(1.0f + __expf(-fabsf(v0[e]))); v1[e] = fminf(v1[e], 0.f) - __logf(1.0f + __expf(-fabsf(v1[e]))); }
                        *(f32x4*)(LF + (size_t)row * 8) = v0; *(f32x4*)(LF + (size_t)row * 8 + 4) = v1; }
            }
        }
    }
};
__device__ __forceinline__ float dpp_ror1(float v) { return __int_as_float(__builtin_amdgcn_update_dpp(0, __float_as_int(v), 0x121, 0xf, 0xf, false)); }
__device__ __forceinline__ float dpp_ror2(float v) { return __int_as_float(__builtin_amdgcn_update_dpp(0, __float_as_int(v), 0x122, 0xf, 0xf, false)); }
struct EpiGlu {
    static constexpr bool PERM = true, AFTER_DRAIN = false; static constexpr int HOOK_EVERY = 0;
    bf16_t* H; float* SG; float* SV; const unsigned long long* ssq; const float* cw; const float* cb;
    __device__ __forceinline__ void operator()(const f32x4 (&acc)[2][2][4][2], const Unit& u, int wr, int wc, int fr, int fq) const {
        const int row0 = u.pm * BM + wr * 64 + fr;
        unsigned long long sq[2][4];
#pragma unroll
        for (int ai = 0; ai < 2; ++ai)
#pragma unroll
            for (int m = 0; m < 4; ++m) sq[ai][m] = ssq[row0 + ai * HALF + m * 16];
        float rsv[2][4];
#pragma unroll
        for (int ai = 0; ai < 2; ++ai)
#pragma unroll
            for (int m = 0; m < 4; ++m) rsv[ai][m] = rsqrtf((float)sq[ai][m] * (SSQ_INV / DM) + NORM_EPS);
#pragma unroll
        for (int n = 0; n < 2; ++n) {
            const int c0 = u.pn * HALF + wc * 32 + 8 * fq + 4 * n;
            const f32x4 w0 = *(const f32x4*)(cw + c0), w1 = *(const f32x4*)(cw + DFF + c0), w2 = *(const f32x4*)(cw + 2 * DFF + c0), bb = *(const f32x4*)(cb + c0);
#pragma unroll
            for (int ai = 0; ai < 2; ++ai) {
                const int blk = u.pm * 4 + ai * 2 + wr;
                f32x4 p1 = (f32x4){0.f, 0.f, 0.f, 0.f}, p2 = p1;
#pragma unroll
                for (int m = 0; m < 4; ++m) { const int row = row0 + ai * HALF + m * 16; const float rs = rsv[ai][m];
                    const f32x4 g = acc[ai][0][m][n] * rs, v = acc[ai][1][m][n] * rs;
                    f32x4 r1, r2;
#pragma unroll
                    for (int e = 0; e < 4; ++e) { r1[e] = dpp_ror1(g[e]); r2[e] = dpp_ror2(g[e]); }
                    const f32x4 q1 = (fr >= 1) ? r1 : p1, q2 = (fr >= 2) ? r2 : p2;
                    p1 = r1; p2 = r2;
                    f32x4 pre = w0 * q2 + w1 * q1 + w2 * g + bb, hv;
#pragma unroll
                    for (int e = 0; e < 4; ++e) hv[e] = pre[e] * __builtin_amdgcn_rcpf(1.0f + __builtin_amdgcn_exp2f(-LOG2E * pre[e])) * v[e];
                    if (m == 0) { if (fr < 2) { *(f32x4*)(SG + ((size_t)blk * 4 + 2 + fr) * DFF + c0) = g; *(f32x4*)(SV + ((size_t)blk * 2 + fr) * DFF + c0) = v; } }
                    if (m == 3) { if (fr >= 14) *(f32x4*)(SG + ((size_t)blk * 4 + (fr - 14)) * DFF + c0) = g; }
                    if (m > 0 || fr >= 2) { u32x2 w; w.x = cvt_pk_bf16(hv[0], hv[1]); w.y = cvt_pk_bf16(hv[2], hv[3]); *(u32x2*)(H + (size_t)row * DFF + c0) = w; }
                    asm volatile("" ::: "memory"); }
            }
        }
    }
};
struct EpiMerge {
    static constexpr bool PERM = true, AFTER_DRAIN = false; static constexpr int HOOK_EVERY = 8;
    bf16_t* O; const bf16_t* G;
    __device__ __forceinline__ void mid(f32x4 (&acc)[2][2][4][2], const Unit& u, int seg, int wr, int wc, int fr, int fq) const {
        int row0 = u.pm * BM + wr * 64 + fr; const int col0 = u.pn * BM + wc * 32 + 8 * fq;
        asm volatile("" : "+v"(row0));
#pragma unroll
        for (int aim = 0; aim < 4; ++aim) { const int ai = aim >> 1, mb = (aim & 1) * 2;
            u32x4 ga[2][2], gb[2][2];
#pragma unroll
            for (int mm = 0; mm < 2; ++mm) { const bf16_t* gp = G + (size_t)(row0 + ai * HALF + (mb + mm) * 16) * G_P + col0 + (seg - 1) * 1024;
#pragma unroll
                for (int bj = 0; bj < 2; ++bj) { ga[mm][bj] = *(const u32x4*)(gp + bj * HALF); gb[mm][bj] = *(const u32x4*)(gp + bj * HALF + 1024); } }
#pragma unroll
            for (int mm = 0; mm < 2; ++mm)
#pragma unroll
                for (int bj = 0; bj < 2; ++bj) { const u32x4 a = ga[mm][bj], b = gb[mm][bj]; const int m = mb + mm;
                    f32x4& a0 = acc[ai][bj][m][0]; f32x4& a1 = acc[ai][bj][m][1];
                    a0[0] *= fmaxf(bflo(a.x), 1e-6f) * __builtin_amdgcn_rcpf(fmaxf(bflo(b.x), 1e-6f)); a0[1] *= fmaxf(bfhi(a.x), 1e-6f) * __builtin_amdgcn_rcpf(fmaxf(bfhi(b.x), 1e-6f));
                    a0[2] *= fmaxf(bflo(a.y), 1e-6f) * __builtin_amdgcn_rcpf(fmaxf(bflo(b.y), 1e-6f)); a0[3] *= fmaxf(bfhi(a.y), 1e-6f) * __builtin_amdgcn_rcpf(fmaxf(bfhi(b.y), 1e-6f));
                    a1[0] *= fmaxf(bflo(a.z), 1e-6f) * __builtin_amdgcn_rcpf(fmaxf(bflo(b.z), 1e-6f)); a1[1] *= fmaxf(bfhi(a.z), 1e-6f) * __builtin_amdgcn_rcpf(fmaxf(bfhi(b.z), 1e-6f));
                    a1[2] *= fmaxf(bflo(a.w), 1e-6f) * __builtin_amdgcn_rcpf(fmaxf(bflo(b.w), 1e-6f)); a1[3] *= fmaxf(bfhi(a.w), 1e-6f) * __builtin_amdgcn_rcpf(fmaxf(bfhi(b.w), 1e-6f)); }
            asm volatile("" ::: "memory"); }
    }
    __device__ __forceinline__ void operator()(const f32x4 (&acc)[2][2][4][2], const Unit& u, int wr, int wc, int fr, int fq) const {
        const int row0 = u.pm * BM + wr * 64 + fr, col0 = u.pn * BM + wc * 32 + 8 * fq;
#pragma unroll
        for (int aim = 0; aim < 4; ++aim) { const int ai = aim >> 1, mb = (aim & 1) * 2;
            u32x4 gv[2][2];
#pragma unroll
            for (int mm = 0; mm < 2; ++mm)
#pragma unroll
                for (int bj = 0; bj < 2; ++bj) gv[mm][bj] = *(const u32x4*)(G + (size_t)(row0 + ai * HALF + (mb + mm) * 16) * G_P + 2048 + col0 + bj * HALF);
#pragma unroll
            for (int mm = 0; mm < 2; ++mm) { const int m = mb + mm; const int row = row0 + ai * HALF + m * 16;
#pragma unroll
                for (int bj = 0; bj < 2; ++bj) { const u32x4 g = gv[mm][bj];
                    const f32x4 a0 = acc[ai][bj][m][0], a1 = acc[ai][bj][m][1];
                    u32x4 w; w.x = cvt_pk_bf16(a0[0] * fmaxf(bflo(g.x), 1e-6f), a0[1] * fmaxf(bfhi(g.x), 1e-6f)); w.y = cvt_pk_bf16(a0[2] * fmaxf(bflo(g.y), 1e-6f), a0[3] * fmaxf(bfhi(g.y), 1e-6f));
                    w.z = cvt_pk_bf16(a1[0] * fmaxf(bflo(g.z), 1e-6f), a1[1] * fmaxf(bfhi(g.z), 1e-6f)); w.w = cvt_pk_bf16(a1[2] * fmaxf(bflo(g.w), 1e-6f), a1[3] * fmaxf(bfhi(g.w), 1e-6f));
                    *(u32x4*)(O + (size_t)row * DM + col0 + bj * HALF) = w; } }
            asm volatile("" ::: "memory"); }
    }
};
struct EpiRes {
    static constexpr bool PERM = false, AFTER_DRAIN = false; static constexpr int HOOK_EVERY = 0;
    const float* Xin; float* X; bf16_t* XB; unsigned long long* ssq_out;
    __device__ __forceinline__ void operator()(const f32x4 (&acc)[2][2][4][2], const Unit& u, int wr, int wc, int fr, int fq) const {
        const int row0 = u.pm * BM + wr * 64 + fr, col0 = u.pn * BM + wc * 32 + 4 * fq;
#pragma unroll
        for (int ai = 0; ai < 2; ++ai)
#pragma unroll
            for (int m = 0; m < 4; ++m) { const int row = row0 + ai * HALF + m * 16; const size_t off = (size_t)row * DM + col0; float s = 0.f;
#pragma unroll
                for (int bj = 0; bj < 2; ++bj)
#pragma unroll
                    for (int n = 0; n < 2; ++n) { const size_t o2 = off + bj * HALF + n * 16; const f32x4 xn = *(const f32x4*)(Xin + o2) + acc[ai][bj][m][n];
                        *(f32x4*)(X + o2) = xn;
                        if (XB) { u32x2 w; w.x = cvt_pk_bf16(xn[0], xn[1]); w.y = cvt_pk_bf16(xn[2], xn[3]); *(u32x2*)(XB + o2) = w; }
                        s += (xn[0] * xn[0] + xn[1] * xn[1]) + (xn[2] * xn[2] + xn[3] * xn[3]); }
                if (ssq_out) { s += __shfl_xor(s, 16); s += __shfl_xor(s, 32); if (fq == 0) atomicAdd(ssq_out + row, (unsigned long long)__float2ll_rn(s * SSQ_SCALE)); } }
    }
};

template <class Epi, class Sched, bool ALIGN_EPI = false, bool SP2 = false>
__device__ __forceinline__ void gemm_phase(PG8_LAS unsigned char* lds, const Gemm g, const Sched& S, const Epi& E) {
    int tid_ = threadIdx.x; asm volatile("" : "+v"(tid_));
    const int tid = tid_, wid = __builtin_amdgcn_readfirstlane(tid >> 6), lane = tid & 63, wr = wid >> 2, wc = wid & 3, fr = lane & 15, fq = lane >> 4;
    const int K = g.K, nt = K / BK;
    unsigned voffA[2], voffB[2];
#pragma unroll
    for (int i = 0; i < 2; ++i) { int R, C; stage_rc(tid * 16 + i * 8192, R, C); const int Rb = Epi::PERM ? ((R & ~31) + perm32(R & 31)) : R;
        voffA[i] = (unsigned)(R * g.lda + C) * 2u; voffB[i] = (unsigned)(Rb * g.ldb + C) * 2u; }
    const size_t kstep = (size_t)(BK * 2);
    const size_t hstepA = (size_t)HALF * g.lda * 2, hstepB = (size_t)HALF * g.ldb * 2;
    const size_t tstepA = 2 * hstepA, tstepB = 2 * hstepB;
    const unsigned ldsw = (unsigned)wid * 1024u;
    const int aoff = lds_byte(wr * 64 + fr, fq * 8), boff = lds_byte(wc * 32 + fr, fq * 8);
#define PG8_SA(b, h) (((b) * 2 + (h)) * HTB)
#define PG8_SB(b, h) ((4 + (b) * 2 + (h)) * HTB)
#define PG8_STAGE(bufoff, gbase, voff) do { _Pragma("unroll") for (int _i = 0; _i < 2; ++_i) \
        __builtin_amdgcn_global_load_lds((const unsigned*)((const char*)(gbase) + (voff)[_i]), (PG8_LAS unsigned*)(lds + (bufoff) + ldsw + _i * 8192), 16, 0, 0); } while (0)
#define PG8_LDA(dst, b, h) do { _Pragma("unroll") for (int m = 0; m < 4; ++m) _Pragma("unroll") for (int k = 0; k < 2; ++k) dst[m][k] = *(const PG8_LAS bf16x8*)(lds + PG8_SA(b, h) + aoff + m * 2048 + k * 1024); } while (0)
#define PG8_LDB(dst, b, h) do { _Pragma("unroll") for (int n = 0; n < 2; ++n) _Pragma("unroll") for (int k = 0; k < 2; ++k) dst[n][k] = *(const PG8_LAS bf16x8*)(lds + PG8_SB(b, h) + boff + n * 2048 + k * 1024); } while (0)
#define PG8_MMA(ai, bj, At, Bt) do { __builtin_amdgcn_s_setprio(1); _Pragma("unroll") for (int m = 0; m < 4; ++m) _Pragma("unroll") for (int n = 0; n < 2; ++n) _Pragma("unroll") for (int k = 0; k < 2; ++k) \
        acc[ai][bj][m][n] = __builtin_amdgcn_mfma_f32_16x16x32_bf16(Bt[n][k], At[m][k], acc[ai][bj][m][n], 0, 0, 0); __builtin_amdgcn_s_setprio(0); } while (0)
#define PG8_WAIT_V(n) asm volatile("s_waitcnt vmcnt(" #n ")" ::: "memory")
#define PG8_WAIT_L(n) asm volatile("s_waitcnt lgkmcnt(" #n ")" ::: "memory")
#define PG8_BAR __builtin_amdgcn_s_barrier()
#define PG8_SCHED __builtin_amdgcn_sched_barrier(0)
    Unit cur, nxt; int ui = 0;
    if (!S.next(0, cur)) return;
    f32x4 acc[2][2][4][2];
#pragma unroll
    for (int a = 0; a < 2; ++a)
#pragma unroll
        for (int b = 0; b < 2; ++b)
#pragma unroll
            for (int m = 0; m < 4; ++m)
#pragma unroll
                for (int n = 0; n < 2; ++n) acc[a][b][m][n] = (f32x4){0.f, 0.f, 0.f, 0.f};
    bf16x8 At[4][2], B0[2][2], B1[2][2];
    const char* cA = (const char*)g.A + (size_t)cur.pm * tstepA + (size_t)(cur.pn / g.a_div) * g.a_colstep; const char* cB = (const char*)g.Bt + (size_t)cur.pn * tstepB;
    S.a_ready(cur);
    if constexpr (SP2) {
        PG8_STAGE(PG8_SB(0, 0), cB, voffB); PG8_STAGE(PG8_SB(0, 1), cB + hstepB, voffB); PG8_STAGE(PG8_SA(0, 0), cA, voffA); PG8_STAGE(PG8_SA(0, 1), cA + hstepA, voffA);
        if (wr == 1) PG8_BAR;
        PG8_WAIT_V(2); PG8_BAR;
        PG8_STAGE(PG8_SB(1, 0), cB + kstep, voffB); PG8_STAGE(PG8_SA(1, 0), cA + kstep, voffA); PG8_STAGE(PG8_SB(1, 1), cB + hstepB + kstep, voffB);
        PG8_WAIT_V(6); PG8_BAR;
    } else {
        PG8_STAGE(PG8_SB(0, 0), cB, voffB); PG8_STAGE(PG8_SA(0, 0), cA, voffA); PG8_STAGE(PG8_SB(0, 1), cB + hstepB, voffB); PG8_STAGE(PG8_SA(0, 1), cA + hstepA, voffA);
        if (wr == 1) PG8_BAR;
        PG8_WAIT_V(4); PG8_BAR;
        PG8_STAGE(PG8_SB(1, 0), cB + kstep, voffB); PG8_STAGE(PG8_SA(1, 0), cA + kstep, voffA); PG8_STAGE(PG8_SB(1, 1), cB + hstepB + kstep, voffB);
        PG8_WAIT_V(6); PG8_BAR;
    }
    for (;;) {
        const bool has_next = S.next(ui + 1, nxt);
        const char* nA = has_next ? (const char*)g.A + (size_t)nxt.pm * tstepA + (size_t)(nxt.pn / g.a_div) * g.a_colstep : cA; const char* nB = has_next ? (const char*)g.Bt + (size_t)nxt.pn * tstepB : cB;
        int tb = 0;
        for (int t = 0; t < nt; t += 2) {
            const bool last = (t == nt - 2);
            if constexpr (Epi::HOOK_EVERY > 0) { if (t > 0 && (t % Epi::HOOK_EVERY) == 0) E.mid(acc, cur, t / Epi::HOOK_EVERY, wr, wc, fr, fq); }
            const char* a1 = cA + (size_t)(t + 1) * kstep;
            const char* a2 = last ? nA : cA + (size_t)(t + 2) * kstep; tb += 2; if (tb >= g.nbt) tb -= g.nbt; const char* b2 = last ? nB : cB + (size_t)tb * kstep;
            const char* a3 = a2 + kstep; const char* b3 = b2 + kstep;
            if (last && has_next) S.a_ready(nxt);
            if constexpr (SP2) {
            PG8_LDB(B0, 0, 0); PG8_LDB(B1, 0, 1); PG8_SCHED; PG8_LDA(At, 0, 0); PG8_STAGE(PG8_SA(1, 1), a1 + hstepA, voffA);
            PG8_WAIT_V(8); PG8_WAIT_L(0); PG8_BAR; PG8_MMA(0, 0, At, B0); PG8_MMA(0, 1, At, B1); PG8_BAR; PG8_SCHED;
            PG8_LDA(At, 0, 1); PG8_STAGE(PG8_SB(0, 0), b2, voffB); PG8_STAGE(PG8_SB(0, 1), b2 + hstepB, voffB); PG8_STAGE(PG8_SA(0, 0), a2, voffA);
            PG8_WAIT_V(8); PG8_WAIT_L(0); PG8_BAR; PG8_MMA(1, 0, At, B0); PG8_MMA(1, 1, At, B1); PG8_BAR; PG8_SCHED;
            PG8_LDB(B0, 1, 0); PG8_LDB(B1, 1, 1); PG8_SCHED; PG8_LDA(At, 1, 0); PG8_STAGE(PG8_SA(0, 1), a2 + hstepA, voffA);
            PG8_WAIT_V(8); PG8_WAIT_L(0); PG8_BAR; PG8_MMA(0, 0, At, B0); PG8_MMA(0, 1, At, B1); PG8_BAR; PG8_SCHED;
            PG8_LDA(At, 1, 1); PG8_STAGE(PG8_SB(1, 0), b3, voffB); PG8_STAGE(PG8_SB(1, 1), b3 + hstepB, voffB); PG8_STAGE(PG8_SA(1, 0), a3, voffA);
            PG8_WAIT_V(8); PG8_WAIT_L(0); PG8_BAR; PG8_MMA(1, 0, At, B0); PG8_MMA(1, 1, At, B1); PG8_BAR; PG8_SCHED;
            } else {
            PG8_LDB(B0, 0, 0); PG8_SCHED; PG8_LDA(At, 0, 0); PG8_STAGE(PG8_SA(1, 1), a1 + hstepA, voffA);
            PG8_WAIT_L(8); PG8_BAR; PG8_WAIT_L(0); PG8_MMA(0, 0, At, B0); PG8_BAR; PG8_SCHED;
            PG8_LDB(B1, 0, 1); PG8_STAGE(PG8_SB(0, 0), b2, voffB);
            PG8_BAR; PG8_WAIT_L(0); PG8_MMA(0, 1, At, B1); PG8_BAR;
            PG8_LDA(At, 0, 1); PG8_STAGE(PG8_SA(0, 0), a2, voffA);
            PG8_BAR; PG8_WAIT_L(0); PG8_MMA(1, 0, At, B0); PG8_BAR; PG8_SCHED;
            PG8_STAGE(PG8_SB(0, 1), b2 + hstepB, voffB);
            PG8_WAIT_V(6); PG8_BAR; PG8_MMA(1, 1, At, B1); PG8_BAR;
            PG8_LDB(B0, 1, 0); PG8_SCHED; PG8_LDA(At, 1, 0); PG8_STAGE(PG8_SA(0, 1), a2 + hstepA, voffA);
            PG8_WAIT_L(8); PG8_BAR; PG8_WAIT_L(0); PG8_MMA(0, 0, At, B0); PG8_BAR; PG8_SCHED;
            PG8_LDB(B1, 1, 1); PG8_STAGE(PG8_SB(1, 0), b3, voffB);
            PG8_BAR; PG8_WAIT_L(0); PG8_MMA(0, 1, At, B1); PG8_BAR;
            PG8_LDA(At, 1, 1); PG8_STAGE(PG8_SA(1, 0), a3, voffA);
            PG8_BAR; PG8_WAIT_L(0); PG8_MMA(1, 0, At, B0); PG8_BAR; PG8_SCHED;
            PG8_STAGE(PG8_SB(1, 1), b3 + hstepB, voffB);
            PG8_WAIT_V(6); PG8_BAR; PG8_MMA(1, 1, At, B1); PG8_BAR;
            }
        }
        if constexpr (ALIGN_EPI) { if (wr == 0) PG8_BAR; }
        if constexpr (!Epi::AFTER_DRAIN) { E(acc, cur, wr, wc, fr, fq); S.done(cur); }
        if (!has_next) break;
#pragma unroll
        for (int a = 0; a < 2; ++a)
#pragma unroll
            for (int b = 0; b < 2; ++b)
#pragma unroll
                for (int m = 0; m < 4; ++m)
#pragma unroll
                    for (int n = 0; n < 2; ++n) acc[a][b][m][n] = (f32x4){0.f, 0.f, 0.f, 0.f};
        cur = nxt; cA = nA; cB = nB; ++ui;
        if constexpr (ALIGN_EPI) { if (wr == 1) PG8_BAR; }
    }
    PG8_WAIT_V(0);
    if constexpr (!ALIGN_EPI) { if (wr == 0) PG8_BAR; }
    PG8_BAR;
    if constexpr (Epi::AFTER_DRAIN) { E.fused(acc, cur, wr, wc, fr, fq, lds, wid, lane); S.done(cur); }
#undef PG8_SA
#undef PG8_SB
#undef PG8_STAGE
#undef PG8_LDA
#undef PG8_LDB
#undef PG8_MMA
#undef PG8_WAIT_V
#undef PG8_WAIT_L
#undef PG8_BAR
#undef PG8_SCHED
}
}

#define LAS __attribute__((address_space(3)))
typedef unsigned short bf16;
typedef unsigned v4u __attribute__((ext_vector_type(4)));
typedef unsigned v2u __attribute__((ext_vector_type(2)));
typedef float f32x4 __attribute__((ext_vector_type(4)));
constexpr int NTHR = 512, NWAVES = 8;
constexpr int LDS_XB_OFF = 131072;
constexpr int LDS_BYTES = 147456;
constexpr size_t MiB = 1u << 20;
constexpr size_t WS_SSQ = 0;
constexpr size_t WS_LF = 1 * MiB;
constexpr size_t WS_BAR = 1 * MiB + 512 * 1024;
constexpr size_t WS_C_UNUSED = 1 * MiB + 768 * 1024;
constexpr size_t WS_XB = 2 * MiB;
constexpr size_t WS_W = 34 * MiB;
constexpr size_t W_IN = 0, W_P = (size_t)NIN * DM * 2, W_OUT = W_P + (size_t)3072 * 512 * 2, W_UP = W_OUT + (size_t)DM * DM * 2, W_DOWN = W_UP + (size_t)NUP * DM * 2, W_LAYER = W_DOWN + (size_t)DM * DFF * 2;
static_assert(W_LAYER == 37 * MiB, "weights per layer");
constexpr size_t WS_PA = WS_W + 4 * W_LAYER;
constexpr size_t WS_YG = WS_PA;
constexpr size_t WS_G = WS_PA + 144 * MiB;
constexpr size_t WS_MIX = WS_G + 96 * MiB;
constexpr size_t WS_U = WS_PA;
constexpr size_t WS_SG = WS_U, WS_SV = WS_U + 16 * MiB;
constexpr size_t WS_H = WS_U + 176 * MiB;
constexpr size_t WS_END = WS_MIX + 48 * MiB;
static_assert(WS_H + 88 * MiB <= WS_END, "ws map");

struct Params {
    const float* x; const float* norm1_g; const float* w_in; const float* fox_f_bias; const float* gate_bias; const float* conv_w;
    const float* fox_q_norm_g; const float* fox_k_norm_g; const float* w_proj_conv; const float* w_proj_fox; const float* w_proj_sb;
    const float* w_out; const float* norm2_g; const float* w_up; const float* ffn_conv_w; const float* ffn_conv_b; const float* w_down;
    float* out; unsigned char* ws;
};

__device__ __forceinline__ unsigned f2bf(float f) { unsigned u = __builtin_bit_cast(unsigned, f); return (u + 0x7fffu + ((u >> 16) & 1u)) >> 16; }
__device__ __forceinline__ unsigned pk2(float lo, float hi) { return f2bf(lo) | (f2bf(hi) << 16); }
__device__ __forceinline__ float blo(unsigned u) { return __uint_as_float(u << 16); }
__device__ __forceinline__ float bhi(unsigned u) { return __uint_as_float(u & 0xffff0000u); }
__device__ __forceinline__ float wave_sum(float v) {
#pragma unroll
    for (int o = 1; o < 64; o <<= 1) v += __shfl_xor(v, o);
    return v;
}
__device__ __forceinline__ void unpack8(const v4u w, float (&f)[8]) { f[0] = blo(w.x); f[1] = bhi(w.x); f[2] = blo(w.y); f[3] = bhi(w.y); f[4] = blo(w.z); f[5] = bhi(w.z); f[6] = blo(w.w); f[7] = bhi(w.w); }

__device__ __forceinline__ void tr_item(const float* W, int ldw, int scol, int nvalid, int ldk, const float* g, bf16* WT, int drow, int nblk, int item, LAS float* scr, int lane, int kofs = 0) {
    const int kb = item / nblk, nb = item % nblk, k0 = 64 * kb, n0 = 32 * nb;
    const int nn = n0 + (lane & 31); const bool ok = nn < nvalid;
    float tv[32];
    const float* src = W + (size_t)(k0 + (lane >> 5)) * ldw + scol + nn;
#pragma unroll
    for (int i = 0; i < 32; ++i) tv[i] = ok ? src[(size_t)(2 * i) * ldw] : 0.f;
    if (g) {
#pragma unroll
        for (int i = 0; i < 32; ++i) tv[i] *= g[k0 + 2 * i + (lane >> 5)];
    }
#pragma unroll
    for (int i = 0; i < 32; ++i) scr[(2 * i + (lane >> 5)) * 33 + (lane & 31)] = tv[i];
    asm volatile("s_waitcnt lgkmcnt(0)" ::: "memory");
    const int c = lane & 7;
#pragma unroll
    for (int j = 0; j < 4; ++j) { const int n = (lane >> 3) + 8 * j; const LAS float* s = scr + (8 * c) * 33 + n;
        v4u o; o.x = pk2(s[0 * 33], s[1 * 33]); o.y = pk2(s[2 * 33], s[3 * 33]); o.z = pk2(s[4 * 33], s[5 * 33]); o.w = pk2(s[6 * 33], s[7 * 33]);
        *(v4u*)(WT + (size_t)(drow + n0 + n) * ldk + kofs + k0 + 8 * c) = o; }
    asm volatile("s_waitcnt lgkmcnt(0)" ::: "memory");
}

__device__ __forceinline__ void prologue(const Params& p, LAS unsigned char* lds, int vcu, int G, int wave, int lane, int tid) {
    LAS float* scr = (LAS float*)(lds + wave * 16384);
    const int gw = vcu * NWAVES + wave, NGW = G * NWAVES;
    constexpr int I0 = 1536, I1 = I0 + 2304, I2 = I1 + 128, I3 = I2 + 768, I4 = I3 + 512, I5 = I4 + 2816, I6 = I5 + 1408;
    for (int it = gw; it < DEPTH * I6; it += NGW) {
        const int l = it / I6; int r = it % I6;
        unsigned char* wl = p.ws + WS_W + (size_t)l * W_LAYER;
        const float* win = p.w_in + (size_t)l * DM * DIN; const float* g1 = p.norm1_g + l * DM;
        if (r < I0) { tr_item(win, DIN, 0, 3072, DM, g1, (bf16*)(wl + W_IN), 0, 96, r, scr, lane); continue; }
        if (r < I1) { tr_item(win, DIN, 3080, 4608, DM, g1, (bf16*)(wl + W_IN), 3072, 144, r - I0, scr, lane); continue; }
        if (r < I2) { tr_item(win, DIN, 3072, 8, DM, g1, (bf16*)(wl + W_IN), 7680, 8, r - I1, scr, lane); continue; }
        if (r < I3) { r -= I2; const int b = r / 256; const float* wp = (b == 0 ? p.w_proj_conv : b == 1 ? p.w_proj_fox : p.w_proj_sb) + (size_t)l * 512 * DM;
                      tr_item(wp, DM, 0, DM, 1536, nullptr, (bf16*)(wl + W_P), 0, 32, r % 256, scr, lane, 512 * b); continue; }
        if (r < I4) { tr_item(p.w_out + (size_t)l * DM * DM, DM, 0, DM, DM, nullptr, (bf16*)(wl + W_OUT), 0, 32, r - I3, scr, lane); continue; }
        if (r < I5) { r -= I4; const int nb = r % 176, j = nb >> 3, q = nb & 7, src = (q < 4) ? 128 * j + 32 * q : DFF + 128 * j + 32 * (q - 4);
                      tr_item(p.w_up + (size_t)l * DM * NUP, NUP, src - 32 * nb, 1 << 30, DM, p.norm2_g + l * DM, (bf16*)(wl + W_UP), 0, 176, r, scr, lane); continue; }
        tr_item(p.w_down + (size_t)l * DFF * DM, DM, 0, DM, DFF, nullptr, (bf16*)(wl + W_DOWN), 0, 32, r - I5, scr, lane);
    }
    unsigned long long* ssq = (unsigned long long*)(p.ws + WS_SSQ); bf16* XB = (bf16*)(p.ws + WS_XB);
    for (int m = gw; m < MTOK; m += NGW) {
        const f32x4* xr = (const f32x4*)(p.x + (size_t)m * DM) + lane; v2u* xb = (v2u*)(XB + (size_t)m * DM) + lane;
        float s = 0.f;
#pragma unroll
        for (int j = 0; j < 4; ++j) { const f32x4 v = xr[64 * j]; v2u w; w.x = pk2(v.x, v.y); w.y = pk2(v.z, v.w); xb[64 * j] = w; s += (v.x * v.x + v.y * v.y) + (v.z * v.z + v.w * v.w); }
        s = wave_sum(s);
        if (lane == 0) ssq[m] = (unsigned long long)__float2ll_rn(s * SSQ_SCALE);
    }
    for (int i = vcu * NTHR + tid; i < 7 * MTOK; i += G * NTHR) ssq[MTOK + i] = 0ull;
}

__device__ __forceinline__ void conv_mixer(const bf16* PA, bf16* MIX, const float* cw, int vcu, int tid) {
    const int r0 = 64 * vcu + 8 * (tid >> 6), c0 = 8 * (tid & 63);
    float w0[8], w1[8], w2[8];
#pragma unroll
    for (int e = 0; e < 8; ++e) { w0[e] = cw[c0 + e]; w1[e] = cw[512 + c0 + e]; w2[e] = cw[1024 + c0 + e]; }
    float p2[8], p1[8];
#pragma unroll
    for (int e = 0; e < 8; ++e) { p2[e] = 0.f; p1[e] = 0.f; }
    const int tseq = r0 % SEQ;
    if (tseq >= 2) {
        float a[8], b[8];
        unpack8(*(const v4u*)(PA + (size_t)(r0 - 2) * PA_P + 512 + c0), a); unpack8(*(const v4u*)(PA + (size_t)(r0 - 2) * PA_P + 1024 + c0), b);
#pragma unroll
        for (int e = 0; e < 8; ++e) p2[e] = a[e] * b[e];
        unpack8(*(const v4u*)(PA + (size_t)(r0 - 1) * PA_P + 512 + c0), a); unpack8(*(const v4u*)(PA + (size_t)(r0 - 1) * PA_P + 1024 + c0), b);
#pragma unroll
        for (int e = 0; e < 8; ++e) p1[e] = a[e] * b[e];
    }
#pragma unroll
    for (int i = 0; i < 8; ++i) {
        const size_t ro = (size_t)(r0 + i) * PA_P;
        float gb[8], a[8], b[8], p0[8];
        unpack8(*(const v4u*)(PA + ro + c0), gb); unpack8(*(const v4u*)(PA + ro + 512 + c0), a); unpack8(*(const v4u*)(PA + ro + 1024 + c0), b);
        float y[8];
#pragma unroll
        for (int e = 0; e < 8; ++e) { p0[e] = a[e] * b[e]; y[e] = gb[e] * (w0[e] * p2[e] + w1[e] * p1[e] + w2[e] * p0[e]); p2[e] = p1[e]; p1[e] = p0[e]; }
        v4u o; o.x = pk2(y[0], y[1]); o.y = pk2(y[2], y[3]); o.z = pk2(y[4], y[5]); o.w = pk2(y[6], y[7]);
        *(v4u*)(MIX + (size_t)(r0 + i) * MIX_P + c0) = o;
    }
}

__device__ __forceinline__ void glu_fixup(const float* SG, const float* SV, bf16* H, const float* cw, const float* cb, int pm, int tid) {
    for (int idx = tid; idx < 8 * 352; idx += NTHR) {
        const int rr = idx / 352, cc = idx % 352, k = rr >> 1, i = rr & 1, c0 = 8 * cc, B = 4 * pm + k, row = 64 * B + i;
        const bool first = (B % (SEQ / 64)) == 0;
#pragma unroll
        for (int hf = 0; hf < 2; ++hf) { const int c = c0 + 4 * hf; const f32x4 z = (f32x4){0.f, 0.f, 0.f, 0.f};
            const f32x4 g0 = *(const f32x4*)(SG + ((size_t)B * 4 + 2 + i) * DFF + c);
            const f32x4 g1 = i ? *(const f32x4*)(SG + ((size_t)B * 4 + 2) * DFF + c) : (first ? z : *(const f32x4*)(SG + ((size_t)(B - 1) * 4 + 1) * DFF + c));
            const f32x4 g2 = first ? z : (i ? *(const f32x4*)(SG + ((size_t)(B - 1) * 4 + 1) * DFF + c) : *(const f32x4*)(SG + ((size_t)(B - 1) * 4 + 0) * DFF + c));
            const f32x4 v = *(const f32x4*)(SV + ((size_t)B * 2 + i) * DFF + c);
            const f32x4 w0 = *(const f32x4*)(cw + c), w1 = *(const f32x4*)(cw + DFF + c), w2 = *(const f32x4*)(cw + 2 * DFF + c), bb = *(const f32x4*)(cb + c);
            const f32x4 pre = w0 * g2 + w1 * g1 + w2 * g0 + bb; f32x4 hv;
#pragma unroll
            for (int e = 0; e < 4; ++e) hv[e] = pre[e] * __builtin_amdgcn_rcpf(1.0f + __builtin_amdgcn_exp2f(-LOG2E * pre[e])) * v[e];
            v2u w; w.x = pk2(hv[0], hv[1]); w.y = pk2(hv[2], hv[3]); *(v2u*)(H + (size_t)row * DFF + c) = w; }
    }
}

__device__ __forceinline__ void fox_scan(const float* LF, float* C, int bh, LAS float* sh, int tid, int wave, int lane) {
    const int b = bh >> 3, h = bh & 7;
    float v[4];
#pragma unroll
    for (int j = 0; j < 4; ++j) v[j] = LF[(size_t)(b * SEQ + 4 * tid + j) * 8 + h];
    v[1] += v[0]; v[2] += v[1]; v[3] += v[2];
    float tot = v[3];
#pragma unroll
    for (int o = 1; o < 64; o <<= 1) { const float n = __shfl_up(tot, o); if (lane >= o) tot += n; }
    if (lane == 63) sh[wave] = tot;
    __syncthreads();
    float base = tot - v[3];
    for (int w = 0; w < wave; ++w) base += sh[w];
#pragma unroll
    for (int j = 0; j < 4; ++j) C[(size_t)bh * SEQ + 4 * tid + j] = base + v[j];
    __syncthreads();
}

namespace att {
typedef float f32x16 __attribute__((ext_vector_type(16)));
typedef short bf16x8 __attribute__((ext_vector_type(8)));
typedef short s16x4 __attribute__((ext_vector_type(4)));
constexpr int KP = 144, VP = 136;
constexpr int KBUF = 64 * KP, VBUF = 64 * VP;
constexpr int OFF_K = 0, OFF_V = 2 * KBUF, OFF_C = OFF_V + 2 * VBUF, OFF_FLAG = OFF_C + SEQ * 4, OFF_SH = OFF_FLAG + 64;
static_assert(OFF_C % 16 == 0, "c array alignment");
__device__ __forceinline__ int crow(int r, int hi) { return (r & 3) + 8 * (r >> 2) + 4 * hi; }
__device__ __forceinline__ float dpp_xor1(float v) { return __int_as_float(__builtin_amdgcn_update_dpp(0, __float_as_int(v), 0xB1, 0xf, 0xf, true)); }
__device__ __forceinline__ float dpp_xor2(float v) { return __int_as_float(__builtin_amdgcn_update_dpp(0, __float_as_int(v), 0x4E, 0xf, 0xf, true)); }
__device__ __forceinline__ float dpp_hmir(float v) { return __int_as_float(__builtin_amdgcn_update_dpp(0, __float_as_int(v), 0x141, 0xf, 0xf, true)); }
__device__ __forceinline__ float xhalf(float v, int hi) { const unsigned u = __float_as_uint(v); auto rr = __builtin_amdgcn_permlane32_swap(u, u, false, false); return __uint_as_float(hi ? rr[0] : rr[1]); }
__device__ __forceinline__ unsigned pkbf(float lo, float hi) { unsigned r; asm volatile("v_cvt_pk_bf16_f32 %0, %1, %2" : "=v"(r) : "v"(lo), "v"(hi)); return r; }

__device__ __forceinline__ void scan_to_lds(const float* LF, int b, int h, LAS unsigned char* lds, int tid, int wave, int lane) {
    LAS float* cL = (LAS float*)(lds + OFF_C); LAS float* sh = (LAS float*)(lds + OFF_SH);
    float v[4];
#pragma unroll
    for (int j = 0; j < 4; ++j) v[j] = LF[(size_t)(b * SEQ + 4 * tid + j) * 8 + h];
    v[1] += v[0]; v[2] += v[1]; v[3] += v[2];
    float tot = v[3];
#pragma unroll
    for (int o = 1; o < 64; o <<= 1) { const float n = __shfl_up(tot, o); if (lane >= o) tot += n; }
    if (lane == 63) sh[wave] = tot;
    __syncthreads();
    float base = tot - v[3];
    for (int w = 0; w < wave; ++w) base += sh[w];
#pragma unroll
    for (int j = 0; j < 4; ++j) cL[4 * tid + j] = (base + v[j]) * LOG2E;
    __syncthreads();
}

template <int MODE>
__device__ __forceinline__ void attn_unit(LAS unsigned char* lds, const bf16* Qg, const bf16* Kg, const bf16* Vg, bf16* Og, int qt,
                                          const float* gq, const float* gk, int tid, int wave, int lane) {
    const int r32 = lane & 31, hi = lane >> 5;
    const int NT = 4 * qt + 4;
    const int qabs = 256 * qt + 32 * wave + r32;
    const int dtile = 4 * qt + (wave >> 1);
    const int srow = tid >> 3, sch = tid & 7;
    bf16x8 qr[4];
    { float qf[4][8]; float ss = 0.f;
#pragma unroll
      for (int d0 = 0; d0 < 4; ++d0) { unpack8(*(const v4u*)(Qg + (size_t)qabs * PA_P + 16 * d0 + 8 * hi), qf[d0]);
#pragma unroll
          for (int e = 0; e < 8; ++e) ss += qf[d0][e] * qf[d0][e]; }
      float sc = 0.125f * LOG2E;
      if (MODE == 0) { ss += __shfl_xor(ss, 32); sc *= rsqrtf(ss * (1.0f / 64.0f) + NORM_EPS); }
#pragma unroll
      for (int d0 = 0; d0 < 4; ++d0) { v4u w;
          if (MODE == 0) { float g[8];
#pragma unroll
              for (int e = 0; e < 8; ++e) g[e] = gq[16 * d0 + 8 * hi + e] * sc;
              w.x = pkbf(qf[d0][0] * g[0], qf[d0][1] * g[1]); w.y = pkbf(qf[d0][2] * g[2], qf[d0][3] * g[3]); w.z = pkbf(qf[d0][4] * g[4], qf[d0][5] * g[5]); w.w = pkbf(qf[d0][6] * g[6], qf[d0][7] * g[7]);
          } else { w.x = pkbf(qf[d0][0] * sc, qf[d0][1] * sc); w.y = pkbf(qf[d0][2] * sc, qf[d0][3] * sc); w.z = pkbf(qf[d0][4] * sc, qf[d0][5] * sc); w.w = pkbf(qf[d0][6] * sc, qf[d0][7] * sc); }
          qr[d0] = __builtin_bit_cast(bf16x8, w); } }
    float gkr[8];
#pragma unroll
    for (int e = 0; e < 8; ++e) gkr[e] = (MODE == 0) ? gk[8 * sch + e] : 1.0f;
    const LAS float* cL = (const LAS float*)(lds + OFF_C);
    const float cq = (MODE == 0) ? cL[qabs] : 0.f;
    f32x16 o[2];
#pragma unroll
    for (int r = 0; r < 16; ++r) { o[0][r] = 0.f; o[1][r] = 0.f; }
    float mrun = 0.f, lrun = 0.f, P = 1.0f;
    v4u kreg, vreg; bool sb_done = false;
#define ATT_GLOAD(T) do { const size_t ro_ = (size_t)(64 * (T) + srow) * PA_P + 8 * sch; kreg = *(const v4u*)(Kg + ro_); vreg = *(const v4u*)(Vg + ro_); } while (0)
#define ATT_STAGE(buf) do { \
        if (MODE == 0) { float kf_[8]; unpack8(kreg, kf_); float s_ = 0.f; _Pragma("unroll") for (int e = 0; e < 8; ++e) s_ += kf_[e] * kf_[e]; \
            s_ += dpp_xor1(s_); s_ += dpp_xor2(s_); s_ += dpp_hmir(s_); const float rs_ = rsqrtf(s_ * (1.0f / 64.0f) + NORM_EPS); \
            kreg.x = pkbf(kf_[0] * rs_ * gkr[0], kf_[1] * rs_ * gkr[1]); kreg.y = pkbf(kf_[2] * rs_ * gkr[2], kf_[3] * rs_ * gkr[3]); \
            kreg.z = pkbf(kf_[4] * rs_ * gkr[4], kf_[5] * rs_ * gkr[5]); kreg.w = pkbf(kf_[6] * rs_ * gkr[6], kf_[7] * rs_ * gkr[7]); } \
        *(LAS v4u*)(lds + OFF_K + (buf) * KBUF + srow * KP + sch * 16) = kreg; \
        LAS unsigned short* vt_ = (LAS unsigned short*)(lds + OFF_V + (buf) * VBUF + (8 * sch) * VP + srow * 2); \
        vt_[0 * (VP / 2)] = (unsigned short)(vreg.x & 0xffffu); vt_[1 * (VP / 2)] = (unsigned short)(vreg.x >> 16); \
        vt_[2 * (VP / 2)] = (unsigned short)(vreg.y & 0xffffu); vt_[3 * (VP / 2)] = (unsigned short)(vreg.y >> 16); \
        vt_[4 * (VP / 2)] = (unsigned short)(vreg.z & 0xffffu); vt_[5 * (VP / 2)] = (unsigned short)(vreg.z >> 16); \
        vt_[6 * (VP / 2)] = (unsigned short)(vreg.w & 0xffffu); vt_[7 * (VP / 2)] = (unsigned short)(vreg.w >> 16); } while (0)
    int it0 = 0;
    if (MODE == 0) { const float cq0 = cL[256 * qt]; while (it0 < 4 * qt && cq0 - cL[64 * it0 + 63] < -130.0f * LOG2E) ++it0; }
    ATT_GLOAD(MODE ? NT - 1 : it0);
    ATT_STAGE(0);
    __syncthreads();
    for (int it = it0; it < NT; ++it) {
        const int tile = MODE ? NT - 1 - it : it, buf = (it - it0) & 1;
        const bool more = it + 1 < NT;
        if (more) ATT_GLOAD(MODE ? tile - 1 : tile + 1);
        if (tile <= dtile && !(MODE == 1 && sb_done)) {
            const int kv0 = 64 * tile;
            f32x16 p0, p1;
            if (MODE == 0) { const float cqm = cq - mrun;
#pragma unroll
                for (int g = 0; g < 4; ++g) { const f32x4 c0 = *(const LAS f32x4*)(cL + kv0 + 8 * g + 4 * hi), c1 = *(const LAS f32x4*)(cL + kv0 + 32 + 8 * g + 4 * hi);
#pragma unroll
                    for (int j = 0; j < 4; ++j) { p0[4 * g + j] = cqm - c0[j]; p1[4 * g + j] = cqm - c1[j]; } }
            } else {
#pragma unroll
                for (int r = 0; r < 16; ++r) { p0[r] = 0.f; p1[r] = 0.f; }
            }
            const LAS unsigned char* kb = lds + OFF_K + buf * KBUF + r32 * KP + hi * 16;
            const LAS unsigned char* vb = lds + OFF_V + buf * VBUF + r32 * VP + hi * 8;
            bf16x8 kf[8];
#pragma unroll
            for (int d0 = 0; d0 < 4; ++d0) { kf[2 * d0] = *(const LAS bf16x8*)(kb + d0 * 32); kf[2 * d0 + 1] = *(const LAS bf16x8*)(kb + 32 * KP + d0 * 32); }
#pragma unroll
            for (int d0 = 0; d0 < 4; ++d0) {
                p0 = __builtin_amdgcn_mfma_f32_32x32x16_bf16(kf[2 * d0], qr[d0], p0, 0, 0, 0);
                p1 = __builtin_amdgcn_mfma_f32_32x32x16_bf16(kf[2 * d0 + 1], qr[d0], p1, 0, 0, 0);
            }
            s16x4 vlo[8], vhi[8];
#pragma unroll
            for (int db = 0; db < 2; ++db)
#pragma unroll
                for (int ks = 0; ks < 4; ++ks) { vlo[db * 4 + ks] = *(const LAS s16x4*)(vb + db * 32 * VP + ks * 32); vhi[db * 4 + ks] = *(const LAS s16x4*)(vb + db * 32 * VP + ks * 32 + 16); }
            const bool diag = (tile == dtile);
            if (MODE == 0) {
                if (diag) {
#pragma unroll
                    for (int r = 0; r < 16; ++r) { const int kv = kv0 + crow(r, hi); if (kv > qabs) p0[r] = -1e30f; if (kv + 32 > qabs) p1[r] = -1e30f; }
                }
                float mx = fmaxf(p0[0], p1[0]);
#pragma unroll
                for (int r = 1; r < 16; ++r) mx = fmaxf(mx, fmaxf(p0[r], p1[r]));
                mx = fmaxf(mx, xhalf(mx, hi));
                if (__any(mx > 8.0f)) {
                    const float dl = fmaxf(mx, 0.f), alpha = __builtin_amdgcn_exp2f(-dl);
                    mrun += dl; lrun *= alpha;
#pragma unroll
                    for (int r = 0; r < 16; ++r) { p0[r] -= dl; p1[r] -= dl; o[0][r] *= alpha; o[1][r] *= alpha; }
                }
                float ls = 0.f;
#pragma unroll
                for (int r = 0; r < 16; ++r) { p0[r] = __builtin_amdgcn_exp2f(p0[r]); p1[r] = __builtin_amdgcn_exp2f(p1[r]); ls += p0[r] + p1[r]; }
                lrun += ls;
            } else {
                float carry = P;
#pragma unroll
                for (int blk = 1; blk >= 0; --blk) {
                    f32x16& pz = blk ? p1 : p0;
                    float u[16], x[16];
#pragma unroll
                    for (int r = 0; r < 16; ++r) { u[r] = __builtin_amdgcn_exp2f(fminf(pz[r], 115.0f)); x[r] = 1.0f + u[r]; }
                    if (diag) {
#pragma unroll
                        for (int r = 0; r < 16; ++r) { const bool act = (kv0 + 32 * blk + crow(r, hi)) < qabs; u[r] = act ? u[r] : 0.f; x[r] = act ? x[r] : 1.0f; }
                    }
                    float s[16], Gown[4], Gp[4], AP[4], AG[4];
#pragma unroll
                    for (int g = 0; g < 4; ++g) { s[4 * g + 3] = 1.0f; s[4 * g + 2] = x[4 * g + 3]; s[4 * g + 1] = s[4 * g + 2] * x[4 * g + 2]; s[4 * g] = s[4 * g + 1] * x[4 * g + 1]; Gown[g] = s[4 * g] * x[4 * g]; }
#pragma unroll
                    for (int g = 0; g < 4; ++g) Gp[g] = xhalf(Gown[g], hi);
                    AP[3] = carry; AP[2] = AP[3] * (Gown[3] * Gp[3]); AP[1] = AP[2] * (Gown[2] * Gp[2]); AP[0] = AP[1] * (Gown[1] * Gp[1]); carry = AP[0] * (Gown[0] * Gp[0]);
#pragma unroll
                    for (int g = 0; g < 4; ++g) AG[g] = hi ? AP[g] : AP[g] * Gp[g];
#pragma unroll
                    for (int r = 0; r < 16; ++r) pz[r] = u[r] * __builtin_amdgcn_rcpf(x[r] * (AG[r >> 2] * s[r]));
                }
                P = carry;
            }
            bf16x8 pb[4];
#pragma unroll
            for (int ks = 0; ks < 4; ++ks) { const f32x16& pz = (ks >> 1) ? p1 : p0; const int rb = 8 * (ks & 1);
                v4u w; w.x = pkbf(pz[rb + 0], pz[rb + 1]); w.y = pkbf(pz[rb + 2], pz[rb + 3]); w.z = pkbf(pz[rb + 4], pz[rb + 5]); w.w = pkbf(pz[rb + 6], pz[rb + 7]);
                pb[ks] = __builtin_bit_cast(bf16x8, w); }
#pragma unroll
            for (int ks = 0; ks < 4; ++ks)
#pragma unroll
                for (int db = 0; db < 2; ++db) {
                    const s16x4 lo = vlo[db * 4 + ks], hh = vhi[db * 4 + ks];
                    const bf16x8 a = (bf16x8){lo[0], lo[1], lo[2], lo[3], hh[0], hh[1], hh[2], hh[3]};
                    o[db] = __builtin_amdgcn_mfma_f32_32x32x16_bf16(a, pb[ks], o[db], 0, 0, 0);
                }
        }
        if (more) ATT_STAGE(buf ^ 1);
        if (MODE == 1) { const int dn_ = __all(P > 1.0e18f) ? 1 : 0; sb_done = dn_ != 0; if (lane == 0) ((LAS int*)(lds + OFF_FLAG))[(it & 1) * 8 + wave] = dn_; }
        __syncthreads();
        if (MODE == 1) { const LAS int* fl = (const LAS int*)(lds + OFF_FLAG) + (it & 1) * 8; int dn = 1;
#pragma unroll
            for (int w = 0; w < 8; ++w) dn &= fl[w];
            if (dn) break; }
    }
#undef ATT_GLOAD
#undef ATT_STAGE
    float inv = 1.0f;
    if (MODE == 0) { const float lt = lrun + __shfl_xor(lrun, 32); inv = 1.0f / lt; }
    bf16* orow = Og + (size_t)qabs * MIX_P;
#pragma unroll
    for (int db = 0; db < 2; ++db)
#pragma unroll
        for (int g = 0; g < 4; ++g) { v2u w; w.x = pkbf(o[db][4 * g] * inv, o[db][4 * g + 1] * inv); w.y = pkbf(o[db][4 * g + 2] * inv, o[db][4 * g + 3] * inv);
            *(v2u*)(orow + 32 * db + 8 * g + 4 * hi) = w; }
}

struct FoxState { bf16x8 qr0, qr1, qr2, qr3; f32x16 o0, o1; float cq, mrun, lrun; int qabs, dtile, it0; };
__device__ __forceinline__ void fox_setup(FoxState& s, const bf16* Qg, int qt, const float* gq, const LAS float* cL, int wave, int r32, int hi, float skip_thr) {
    s.qabs = 256 * qt + 32 * wave + r32; s.dtile = 4 * qt + (wave >> 1);
    int it0 = 0; { const float cq0 = cL[256 * qt]; while (it0 < 4 * qt && cq0 - cL[64 * it0 + 63] < skip_thr) ++it0; }
    s.it0 = it0;
    float qf[4][8]; float ss = 0.f;
#pragma unroll
    for (int d0 = 0; d0 < 4; ++d0) { unpack8(*(const v4u*)(Qg + (size_t)s.qabs * PA_P + 16 * d0 + 8 * hi), qf[d0]);
#pragma unroll
        for (int e = 0; e < 8; ++e) ss += qf[d0][e] * qf[d0][e]; }
    ss += __shfl_xor(ss, 32);
    const float sc = 0.125f * LOG2E * rsqrtf(ss * (1.0f / 64.0f) + NORM_EPS);
    bf16x8 q[4];
#pragma unroll
    for (int d0 = 0; d0 < 4; ++d0) { float g[8];
#pragma unroll
        for (int e = 0; e < 8; ++e) g[e] = gq[16 * d0 + 8 * hi + e] * sc;
        v4u w; w.x = pkbf(qf[d0][0] * g[0], qf[d0][1] * g[1]); w.y = pkbf(qf[d0][2] * g[2], qf[d0][3] * g[3]); w.z = pkbf(qf[d0][4] * g[4], qf[d0][5] * g[5]); w.w = pkbf(qf[d0][6] * g[6], qf[d0][7] * g[7]);
        q[d0] = __builtin_bit_cast(bf16x8, w); }
    s.qr0 = q[0]; s.qr1 = q[1]; s.qr2 = q[2]; s.qr3 = q[3];
    s.cq = cL[s.qabs]; s.mrun = 0.f; s.lrun = 0.f;
#pragma unroll
    for (int r = 0; r < 16; ++r) { s.o0[r] = 0.f; s.o1[r] = 0.f; }
}
__device__ __forceinline__ void fox_tile(FoxState& s, LAS unsigned char* lds, const LAS float* cL, int tile, int buf, int r32, int hi) {
    const int kv0 = 64 * tile;
    f32x16 p0, p1;
    { const float cqm = s.cq - s.mrun;
#pragma unroll
      for (int g = 0; g < 4; ++g) { const f32x4 c0 = *(const LAS f32x4*)(cL + kv0 + 8 * g + 4 * hi), c1 = *(const LAS f32x4*)(cL + kv0 + 32 + 8 * g + 4 * hi);
#pragma unroll
          for (int j = 0; j < 4; ++j) { p0[4 * g + j] = cqm - c0[j]; p1[4 * g + j] = cqm - c1[j]; } } }
    const LAS unsigned char* kb = lds + OFF_K + buf * KBUF + r32 * KP + hi * 16;
    const LAS unsigned char* vb = lds + OFF_V + buf * VBUF + r32 * VP + hi * 8;
    bf16x8 kf[8];
#pragma unroll
    for (int d0 = 0; d0 < 4; ++d0) { kf[2 * d0] = *(const LAS bf16x8*)(kb + d0 * 32); kf[2 * d0 + 1] = *(const LAS bf16x8*)(kb + 32 * KP + d0 * 32); }
    p0 = __builtin_amdgcn_mfma_f32_32x32x16_bf16(kf[0], s.qr0, p0, 0, 0, 0); p1 = __builtin_amdgcn_mfma_f32_32x32x16_bf16(kf[1], s.qr0, p1, 0, 0, 0);
    p0 = __builtin_amdgcn_mfma_f32_32x32x16_bf16(kf[2], s.qr1, p0, 0, 0, 0); p1 = __builtin_amdgcn_mfma_f32_32x32x16_bf16(kf[3], s.qr1, p1, 0, 0, 0);
    p0 = __builtin_amdgcn_mfma_f32_32x32x16_bf16(kf[4], s.qr2, p0, 0, 0, 0); p1 = __builtin_amdgcn_mfma_f32_32x32x16_bf16(kf[5], s.qr2, p1, 0, 0, 0);
    p0 = __builtin_amdgcn_mfma_f32_32x32x16_bf16(kf[6], s.qr3, p0, 0, 0, 0); p1 = __builtin_amdgcn_mfma_f32_32x32x16_bf16(kf[7], s.qr3, p1, 0, 0, 0);
    s16x4 vlo[8], vhi[8];
#pragma unroll
    for (int db = 0; db < 2; ++db)
#pragma unroll
        for (int ks = 0; ks < 4; ++ks) { vlo[db * 4 + ks] = *(const LAS s16x4*)(vb + db * 32 * VP + ks * 32); vhi[db * 4 + ks] = *(const LAS s16x4*)(vb + db * 32 * VP + ks * 32 + 16); }
    if (tile == s.dtile) {
#pragma unroll
        for (int r = 0; r < 16; ++r) { const int kv = kv0 + crow(r, hi); if (kv > s.qabs) p0[r] = -1e30f; if (kv + 32 > s.qabs) p1[r] = -1e30f; }
    }
    float mx = fmaxf(p0[0], p1[0]);
#pragma unroll
    for (int r = 1; r < 16; ++r) mx = fmaxf(mx, fmaxf(p0[r], p1[r]));
    mx = fmaxf(mx, xhalf(mx, hi));
    if (__any(mx > 8.0f)) {
        const float dl = fmaxf(mx, 0.f), alpha = __builtin_amdgcn_exp2f(-dl);
        s.mrun += dl; s.lrun *= alpha;
#pragma unroll
        for (int r = 0; r < 16; ++r) { p0[r] -= dl; p1[r] -= dl; s.o0[r] *= alpha; s.o1[r] *= alpha; }
    }
    float ls = 0.f;
#pragma unroll
    for (int r = 0; r < 16; ++r) { p0[r] = __builtin_amdgcn_exp2f(p0[r]); p1[r] = __builtin_amdgcn_exp2f(p1[r]); ls += p0[r] + p1[r]; }
    s.lrun += ls;
    bf16x8 pb[4];
#pragma unroll
    for (int ks = 0; ks < 4; ++ks) { const f32x16& pz = (ks >> 1) ? p1 : p0; const int rb = 8 * (ks & 1);
        v4u w; w.x = pkbf(pz[rb + 0], pz[rb + 1]); w.y = pkbf(pz[rb + 2], pz[rb + 3]); w.z = pkbf(pz[rb + 4], pz[rb + 5]); w.w = pkbf(pz[rb + 6], pz[rb + 7]);
        pb[ks] = __builtin_bit_cast(bf16x8, w); }
#pragma unroll
    for (int ks = 0; ks < 4; ++ks) {
        { const s16x4 lo = vlo[ks], hh = vhi[ks]; const bf16x8 a = (bf16x8){lo[0], lo[1], lo[2], lo[3], hh[0], hh[1], hh[2], hh[3]}; s.o0 = __builtin_amdgcn_mfma_f32_32x32x16_bf16(a, pb[ks], s.o0, 0, 0, 0); }
        { const s16x4 lo = vlo[4 + ks], hh = vhi[4 + ks]; const bf16x8 a = (bf16x8){lo[0], lo[1], lo[2], lo[3], hh[0], hh[1], hh[2], hh[3]}; s.o1 = __builtin_amdgcn_mfma_f32_32x32x16_bf16(a, pb[ks], s.o1, 0, 0, 0); }
    }
}
__device__ __forceinline__ void fox_store(const FoxState& s, bf16* Og, int hi) {
    const float lt = s.lrun + __shfl_xor(s.lrun, 32), inv = 1.0f / lt;
    bf16* orow = Og + (size_t)s.qabs * MIX_P;
#pragma unroll
    for (int g = 0; g < 4; ++g) { v2u w; w.x = pkbf(s.o0[4 * g] * inv, s.o0[4 * g + 1] * inv); w.y = pkbf(s.o0[4 * g + 2] * inv, s.o0[4 * g + 3] * inv); *(v2u*)(orow + 8 * g + 4 * hi) = w; }
#pragma unroll
    for (int g = 0; g < 4; ++g) { v2u w; w.x = pkbf(s.o1[4 * g] * inv, s.o1[4 * g + 1] * inv); w.y = pkbf(s.o1[4 * g + 2] * inv, s.o1[4 * g + 3] * inv); *(v2u*)(orow + 32 + 8 * g + 4 * hi) = w; }
}
__device__ __forceinline__ void fox_pair(LAS unsigned char* lds, const bf16* Qg, const bf16* Kg, const bf16* Vg, bf16* Og, int qtA, int qtB,
                                         const float* gq, const float* gk, int tid, int wave, int lane) {
    const int r32 = lane & 31, hi = lane >> 5, srow = tid >> 3, sch = tid & 7;
    const LAS float* cL = (const LAS float*)(lds + OFF_C);
    FoxState A, B;
    float gqm = fabsf(gq[lane]), gkm = fabsf(gk[lane]);
#pragma unroll
    for (int o_ = 1; o_ < 64; o_ <<= 1) { gqm = fmaxf(gqm, __shfl_xor(gqm, o_)); gkm = fmaxf(gkm, __shfl_xor(gkm, o_)); }
    const float skip_thr = -(2.0f * 8.0f * gqm * gkm + 40.0f) * LOG2E;
    int itA0 = 0; { const float cq0 = cL[256 * qtA]; while (itA0 < 4 * qtA && cq0 - cL[64 * itA0 + 63] < skip_thr) ++itA0; }
    v4u kreg, vreg;
    { const size_t ro_ = (size_t)(64 * itA0 + srow) * PA_P + 8 * sch; kreg = *(const v4u*)(Kg + ro_); vreg = *(const v4u*)(Vg + ro_); }
    fox_setup(A, Qg, qtA, gq, cL, wave, r32, hi, skip_thr);
    fox_setup(B, Qg, qtB, gq, cL, wave, r32, hi, skip_thr);
    const int lastA = 4 * qtA + 3, lastB = 4 * qtB + 3;
    const int jump = (B.it0 > lastA + 1) ? B.it0 : lastA + 1;
    float gkr[8];
#pragma unroll
    for (int e = 0; e < 8; ++e) gkr[e] = gk[8 * sch + e];
#define FP_GLOAD(T) do { const size_t ro_ = (size_t)(64 * (T) + srow) * PA_P + 8 * sch; kreg = *(const v4u*)(Kg + ro_); vreg = *(const v4u*)(Vg + ro_); } while (0)
#define FP_STAGE(buf) do { \
        float kf_[8]; unpack8(kreg, kf_); float s_ = 0.f; _Pragma("unroll") for (int e = 0; e < 8; ++e) s_ += kf_[e] * kf_[e]; \
        s_ += dpp_xor1(s_); s_ += dpp_xor2(s_); s_ += dpp_hmir(s_); const float rs_ = rsqrtf(s_ * (1.0f / 64.0f) + NORM_EPS); \
        v4u kn_; kn_.x = pkbf(kf_[0] * rs_ * gkr[0], kf_[1] * rs_ * gkr[1]); kn_.y = pkbf(kf_[2] * rs_ * gkr[2], kf_[3] * rs_ * gkr[3]); \
        kn_.z = pkbf(kf_[4] * rs_ * gkr[4], kf_[5] * rs_ * gkr[5]); kn_.w = pkbf(kf_[6] * rs_ * gkr[6], kf_[7] * rs_ * gkr[7]); \
        *(LAS v4u*)(lds + OFF_K + (buf) * KBUF + srow * KP + sch * 16) = kn_; \
        LAS unsigned short* vt_ = (LAS unsigned short*)(lds + OFF_V + (buf) * VBUF + (8 * sch) * VP + srow * 2); \
        vt_[0 * (VP / 2)] = (unsigned short)(vreg.x & 0xffffu); vt_[1 * (VP / 2)] = (unsigned short)(vreg.x >> 16); \
        vt_[2 * (VP / 2)] = (unsigned short)(vreg.y & 0xffffu); vt_[3 * (VP / 2)] = (unsigned short)(vreg.y >> 16); \
        vt_[4 * (VP / 2)] = (unsigned short)(vreg.z & 0xffffu); vt_[5 * (VP / 2)] = (unsigned short)(vreg.z >> 16); \
        vt_[6 * (VP / 2)] = (unsigned short)(vreg.w & 0xffffu); vt_[7 * (VP / 2)] = (unsigned short)(vreg.w >> 16); } while (0)
    int t = A.it0, buf = 0;
    FP_STAGE(0);
    __syncthreads();
    while (t <= lastB) {
        const int tn = (t == lastA) ? jump : t + 1;
        const bool more = tn <= lastB;
        if (more) FP_GLOAD(tn);
        if (t <= A.dtile) fox_tile(A, lds, cL, t, buf, r32, hi);
        if (t >= B.it0 && t <= B.dtile) fox_tile(B, lds, cL, t, buf, r32, hi);
        if (more) FP_STAGE(buf ^ 1);
        __syncthreads();
        t = tn; buf ^= 1;
    }
#undef FP_GLOAD
#undef FP_STAGE
    fox_store(A, Og, hi); fox_store(B, Og, hi);
}
}

#define XB_TMO      128
#define XB_XCNT(j)  (256  + 64 * (j))
#define XB_XSUB(j)  (1280 + 64 * (j))
#define XB_XGEN(j)  (2304 + 64 * (j))
#define XB_TOP      3328
#define XB_TOPGEN   3392
#define XCD_BAR_WORDS 3456
#define XB_SPIN_CAP (1u << 18)

__device__ __forceinline__ unsigned xb_ld(unsigned* p)              { return __hip_atomic_load(p, __ATOMIC_RELAXED, __HIP_MEMORY_SCOPE_AGENT); }
__device__ __forceinline__ unsigned xb_add(unsigned* p, unsigned v) { return __hip_atomic_fetch_add(p, v, __ATOMIC_RELAXED, __HIP_MEMORY_SCOPE_AGENT); }
__device__ __forceinline__ unsigned xb_xcc_id() { return (unsigned)__builtin_amdgcn_s_getreg((3 << 11) | 20) & 0xFu; }
#define XB_SPIN(cond, bar) do { unsigned _sp = 0; while (cond) { __builtin_amdgcn_s_sleep(1); \
    if ((++_sp & 255u) == 0u) { if (xb_ld(&(bar)[XB_TMO])) break; if (_sp > XB_SPIN_CAP) { atomicAdd(&(bar)[XB_TMO], 1u); break; } } } } while (0)

struct XcdBarrier {
    unsigned* bar; unsigned x;
    volatile LAS unsigned* st;
};

__device__ __forceinline__ XcdBarrier xcd_barrier_post(unsigned* bar, volatile LAS unsigned* st) {
    XcdBarrier b; b.bar = bar; b.x = xb_xcc_id(); b.st = st;
    if (threadIdx.x == 0) (void)xb_add(&bar[XB_XCNT(b.x)], 1u);
    return b;
}
__device__ __forceinline__ void xcd_barrier_complete(unsigned* bar, unsigned x, unsigned& nloc, unsigned& nx) {
    const unsigned G = gridDim.x * gridDim.y * gridDim.z;
    unsigned sum, cnt, mine, sp = 0u;
    for (;;) {
        sum = 0u; cnt = 0u; mine = 0u;
#pragma unroll
        for (unsigned j = 0; j < 16; ++j) { const unsigned c = xb_ld(&bar[XB_XCNT(j)]); sum += c; cnt += (c > 0u) ? 1u : 0u; mine = (j == x) ? c : mine; }
        if (sum == G) break;
        __builtin_amdgcn_s_sleep(1);
        if ((++sp & 255u) == 0u) { if (xb_ld(&bar[XB_TMO])) break; if (sp > XB_SPIN_CAP) { atomicAdd(&bar[XB_TMO], 1u); break; } }
    }
    nloc = mine > 0u ? mine : 1u; nx = cnt > 0u ? cnt : 1u;
}

__device__ __forceinline__ void xcd_barrier(const XcdBarrier& b) {
    asm volatile("s_waitcnt vmcnt(0)" ::: "memory");
    __syncthreads();
    if (threadIdx.x == 0) {
        unsigned* bar = b.bar; unsigned bxx = b.x; asm volatile("" : "+s"(bar), "+s"(bxx));
        __builtin_amdgcn_s_waitcnt(0);
        unsigned nloc = b.st[0], nx = b.st[1];
        if (nloc == 0u) { xcd_barrier_complete(bar, bxx, nloc, nx); b.st[0] = nloc; b.st[1] = nx; }
        const unsigned old = xb_add(&bar[XB_XSUB(bxx)], 1u);
        const unsigned gen = old / nloc;
        if (old + 1u == (gen + 1u) * nloc) {
            __builtin_amdgcn_fence(__ATOMIC_RELEASE, "agent");
            asm volatile("s_waitcnt vmcnt(0)" ::: "memory");
            const unsigned og = xb_add(&bar[XB_TOP], 1u);
            const unsigned tg = og / nx;
            if (og + 1u == (tg + 1u) * nx) xb_add(&bar[XB_TOPGEN], 1u);
            else XB_SPIN(xb_ld(&bar[XB_TOPGEN]) == tg, bar);
            __builtin_amdgcn_fence(__ATOMIC_ACQUIRE, "agent");
            xb_add(&bar[XB_XGEN(bxx)], 1u);
            asm volatile("s_waitcnt vmcnt(0)" ::: "memory");
        } else {
            XB_SPIN(xb_ld(&bar[XB_XGEN(bxx)]) == gen, bar);
            __builtin_amdgcn_fence(__ATOMIC_ACQUIRE, "agent");
            asm volatile("s_waitcnt vmcnt(0)" ::: "memory");
        }
    }
    __syncthreads();
}

#define CW_XT    4096
#define CW_FLAG  4608
#define CW_LOC(x) (5120 + 64 * (x))
#define CTL_MEMSET_BYTES 32768
__device__ __forceinline__ void xcd_local_barrier(unsigned* ctl, int grp, unsigned& lgen, const bool is_t0) {
    asm volatile("s_waitcnt vmcnt(0) lgkmcnt(0)" ::: "memory");
    __syncthreads();
    if (is_t0) {
        asm volatile("" : "+s"(ctl));
        unsigned* cnt = ctl + CW_LOC(grp);
        (void)xb_add(cnt, 1u);
        const unsigned target = (lgen + 1u) * 32u;
        XB_SPIN(xb_ld(cnt) < target, ctl);
        __builtin_amdgcn_fence(__ATOMIC_ACQUIRE, "agent");
        asm volatile("s_waitcnt vmcnt(0)" ::: "memory");
    }
    lgen += 1u;
    __syncthreads();
}

__device__ __forceinline__ const Params* kargs() { const Params* q = (const Params*)__builtin_amdgcn_kernarg_segment_ptr(); asm volatile("" : "+s"(q)); return q; }
#define WSP(T, off) ((T*)(P->ws + (off)))
#define CGSYNC() do { asm volatile("s_waitcnt vmcnt(0) lgkmcnt(0)" ::: "memory"); __syncthreads(); \
    if (wave == 0) { __builtin_amdgcn_fence(__ATOMIC_RELEASE, "agent"); asm volatile("s_waitcnt vmcnt(0)" ::: "memory"); } \
    cg::this_grid().sync(); \
    if (wave == 0) { __builtin_amdgcn_fence(__ATOMIC_ACQUIRE, "agent"); asm volatile("s_waitcnt vmcnt(0)" ::: "memory"); } \
    __syncthreads(); } while (0)
#define GSYNC_GLOBAL() do { asm volatile("s_waitcnt lgkmcnt(0)" ::: "memory"); xcd_barrier(xbar); } while (0)
#define GSYNC() do { if (loc_mode) xcd_local_barrier(ctlw, bx & 7, lgen, threadIdx.x == 0); else GSYNC_GLOBAL(); } while (0)
__global__ void __launch_bounds__(NTHR, 2) fwd_megakernel(Params p_arg) {
    extern __shared__ __attribute__((aligned(16))) unsigned char lds_raw[];
    LAS unsigned char* lds = (LAS unsigned char*)lds_raw;
    const int tid = threadIdx.x, lane = tid & 63, wave = __builtin_amdgcn_readfirstlane(tid >> 6);
    const int G = gridDim.x, bx = blockIdx.x;
    const int vcu = (G % 8 == 0) ? (bx % 8) * (G / 8) + bx / 8 : bx;

    volatile LAS unsigned* xst = (volatile LAS unsigned*)(lds + LDS_XB_OFF);
    if (tid < 4) xst[tid] = 0u;
    __syncthreads();
    const XcdBarrier xbar = xcd_barrier_post((unsigned*)(p_arg.ws + WS_BAR), xst);
    unsigned* ctlw = (unsigned*)(p_arg.ws + WS_BAR);
    if (tid == 0) __hip_atomic_store(ctlw + CW_XT + bx, xbar.x + 1u, __ATOMIC_RELAXED, __HIP_MEMORY_SCOPE_AGENT);
    { const Params* P = &p_arg; prologue(*P, lds, vcu, G, wave, lane, tid); }
    if (p_arg.ws == nullptr) CGSYNC();
    GSYNC_GLOBAL();
    if (wave == 0) { bool bad = false;
        if (G == 256) { if (lane < 32) bad = __hip_atomic_load(ctlw + CW_XT + (bx & 7) + 8 * lane, __ATOMIC_RELAXED, __HIP_MEMORY_SCOPE_AGENT) != xbar.x + 1u; } else bad = true;
        if (__any(bad) && lane == 0) (void)xb_add(ctlw + CW_FLAG, 1u); }
    GSYNC_GLOBAL();
    const bool loc_mode = __builtin_amdgcn_readfirstlane((int)__hip_atomic_load(ctlw + CW_FLAG, __ATOMIC_RELAXED, __HIP_MEMORY_SCOPE_AGENT)) == 0;
    unsigned lgen = 0u;

#pragma unroll 1
    for (int l = 0; l < DEPTH; ++l) {
        { const Params* P = &p_arg; const unsigned char* wl = P->ws + WS_W + (size_t)l * W_LAYER;
          pg8::Gemm g{WSP(bf16, WS_XB), (const bf16*)(wl + W_IN), MTOK, NIN, DM, DM, DM, 1 << 20, 0, 16}; pg8::StaticOrder S; S.init(MTOK, NIN, G, bx);
          pg8::EpiIn E{WSP(bf16, WS_PA), WSP(bf16, WS_G), WSP(float, WS_LF), WSP(unsigned long long, WS_SSQ) + (size_t)(2 * l) * MTOK, P->gate_bias + l * 3072, P->fox_f_bias + l * 8};
          pg8::gemm_phase<pg8::EpiIn, pg8::StaticOrder, true, true>(lds, g, S, E); }
        GSYNC();
        { const Params* P = &p_arg; int tid = threadIdx.x; asm volatile("" : "+v"(tid)); const int lane = tid & 63;
          for (int v = vcu; v < MTOK / 64; v += G) conv_mixer(WSP(bf16, WS_PA), WSP(bf16, WS_MIX), P->conv_w + l * 1536, v, tid);
#pragma unroll 1
          for (int wv = vcu; wv < 256; wv += G) {
            const int bh = wv >> 2, pr = wv & 3, b = bh >> 3, h = bh & 7;
            att::scan_to_lds(WSP(float, WS_LF), b, h, lds, tid, wave, lane);
            const bf16* PAb = WSP(bf16, WS_PA) + (size_t)b * SEQ * PA_P + h * 64; bf16* MIXb = WSP(bf16, WS_MIX) + (size_t)b * SEQ * MIX_P + h * 64;
            att::fox_pair(lds, PAb + 1536, PAb + 2048, PAb + 2560, MIXb + 512, pr, 7 - pr, P->fox_q_norm_g + l * 64, P->fox_k_norm_g + l * 64, tid, wave, lane);
#pragma unroll 1
            for (int k = 0; k < 2; ++k) att::attn_unit<1>(lds, PAb + 3072, PAb + 3584, PAb + 4096, MIXb + 1024, 2 * (3 - pr) + k, nullptr, nullptr, tid, wave, lane);
          } }
        GSYNC();
        { const Params* P = &p_arg; const unsigned char* wl = P->ws + WS_W + (size_t)l * W_LAYER;
          pg8::Gemm g{WSP(bf16, WS_MIX), (const bf16*)(wl + W_P), MTOK, DM, 1536, MIX_P, 1536, 1 << 20, 0, 24}; pg8::StaticOrder S; S.init(MTOK, DM, G, bx);
          pg8::EpiMerge E{WSP(bf16, WS_YG), WSP(bf16, WS_G)};
          pg8::gemm_phase<pg8::EpiMerge, pg8::StaticOrder, true, true>(lds, g, S, E); }
        GSYNC();
        { const Params* P = &p_arg; const unsigned char* wl = P->ws + WS_W + (size_t)l * W_LAYER;
          pg8::Gemm g{WSP(bf16, WS_YG), (const bf16*)(wl + W_OUT), MTOK, DM, DM, DM, DM, 1 << 20, 0, 16}; pg8::StaticOrder S; S.init(MTOK, DM, G, bx);
          pg8::EpiRes E{l == 0 ? P->x : P->out, P->out, WSP(bf16, WS_XB), WSP(unsigned long long, WS_SSQ) + (size_t)(2 * l + 1) * MTOK};
          pg8::gemm_phase<pg8::EpiRes, pg8::StaticOrder, true, true>(lds, g, S, E); }
        GSYNC();
        { const Params* P = &p_arg; const unsigned char* wl = P->ws + WS_W + (size_t)l * W_LAYER;
          pg8::Gemm g{WSP(bf16, WS_XB), (const bf16*)(wl + W_UP), MTOK, NUP, DM, DM, DM, 1 << 20, 0, 16}; pg8::StaticOrder S; S.init(MTOK, NUP, G, bx);
          pg8::EpiGlu E{WSP(bf16, WS_H), WSP(float, WS_SG), WSP(float, WS_SV), WSP(unsigned long long, WS_SSQ) + (size_t)(2 * l + 1) * MTOK, P->ffn_conv_w + l * 3 * DFF, P->ffn_conv_b + l * DFF};
          pg8::gemm_phase<pg8::EpiGlu, pg8::StaticOrder, true, true>(lds, g, S, E); }
        GSYNC();
        { const Params* P = &p_arg; const unsigned char* wl = P->ws + WS_W + (size_t)l * W_LAYER;
          pg8::Gemm g{WSP(bf16, WS_H), (const bf16*)(wl + W_DOWN), MTOK, DM, DFF, DFF, DFF, 1 << 20, 0, 44}; pg8::StaticOrder S; S.init(MTOK, DM, G, bx);
          { int tid = threadIdx.x; asm volatile("" : "+v"(tid)); pg8::Unit u;
            for (int i = 0; S.next(i, u); ++i) glu_fixup(WSP(float, WS_SG), WSP(float, WS_SV), WSP(bf16, WS_H), P->ffn_conv_w + l * 3 * DFF, P->ffn_conv_b + l * DFF, u.pm, tid);
            asm volatile("s_waitcnt vmcnt(0)" ::: "memory"); __syncthreads(); }
          const bool lastl = (l == DEPTH - 1);
          pg8::EpiRes E{P->out, P->out, lastl ? nullptr : WSP(bf16, WS_XB), lastl ? nullptr : WSP(unsigned long long, WS_SSQ) + (size_t)(2 * l + 2) * MTOK};
          pg8::gemm_phase<pg8::EpiRes, pg8::StaticOrder, true, true>(lds, g, S, E); }
        GSYNC();
    }
}

extern "C" void kernel_launch(void* const* d_in, const int* in_sizes, int n_in, void* d_out, int out_size, void* d_ws, size_t ws_size, hipStream_t stream) {
    static int grid = 0;
    if (grid == 0) {
        int dev = 0, cus = 0, per_cu = 0;
        hipGetDevice(&dev);
        hipDeviceGetAttribute(&cus, hipDeviceAttributeMultiprocessorCount, dev);
        hipFuncSetAttribute((const void*)fwd_megakernel, hipFuncAttributeMaxDynamicSharedMemorySize, LDS_BYTES);
        hipOccupancyMaxActiveBlocksPerMultiprocessor(&per_cu, (const void*)fwd_megakernel, NTHR, LDS_BYTES);
        if (per_cu < 1) per_cu = 1;
        grid = cus * 1;
        if (ws_size < WS_END) fprintf(stderr, "kernel_launch: workspace too small (%zu < %zu)\n", ws_size, (size_t)WS_END);
    }
    Params p{};
    p.x = (const float*)d_in[0]; p.norm1_g = (const float*)d_in[1]; p.w_in = (const float*)d_in[2]; p.fox_f_bias = (const float*)d_in[3];
    p.gate_bias = (const float*)d_in[4]; p.conv_w = (const float*)d_in[5]; p.fox_q_norm_g = (const float*)d_in[6]; p.fox_k_norm_g = (const float*)d_in[7];
    p.w_proj_conv = (const float*)d_in[8]; p.w_proj_fox = (const float*)d_in[9]; p.w_proj_sb = (const float*)d_in[10]; p.w_out = (const float*)d_in[11];
    p.norm2_g = (const float*)d_in[12]; p.w_up = (const float*)d_in[13]; p.ffn_conv_w = (const float*)d_in[14]; p.ffn_conv_b = (const float*)d_in[15];
    p.w_down = (const float*)d_in[16]; p.out = (float*)d_out; p.ws = (unsigned char*)d_ws;
    (void)hipMemsetAsync((char*)d_ws + WS_BAR, 0, CTL_MEMSET_BYTES, stream);
    void* args[] = {&p};
    hipError_t e = hipLaunchCooperativeKernel((const void*)fwd_megakernel, dim3(grid), dim3(NTHR), args, LDS_BYTES, stream);
    if (e != hipSuccess) fprintf(stderr, "cooperative launch failed: %s (grid %d)\n", hipGetErrorString(e), grid);
}
```
